# Optimizing an MI355X kernel written in HIP

```python
import jax, jax.numpy as jnp
from jax import lax
import numpy as np

D_MODEL = 1024
BATCH = 32
SEQ = 256
DEPTH = 4
DEC_BATCH = 2
DEC_SEQ = 4096
PAST_LEN = 512

GRID_W = 64
HEAD_DIM = 64
NA_HEADS = 4
NA_KH = 8
NA_KW = 16
NA_QCOLS = 16
NA_KCOLS = 32
GQA_Q_HEADS = 8
GQA_KV_HEADS = 2
Q_BLOCK = 128
ROPE_THETA = 10000.0
GLA_HEADS = 4
GLA_DK = 64
GLA_DV = 64
GLA_RANK = 16
GLA_TAU = 16.0
GLA_CHUNK = 16
D_FF = 2816
CONV_W = 3
EPS = 1e-6
NEG_INF = -1e30

W_A = NA_HEADS * HEAD_DIM
W_BQ = GQA_Q_HEADS * HEAD_DIM
W_BKV = GQA_KV_HEADS * HEAD_DIM
W_CK = GLA_HEADS * GLA_DK
W_CV = GLA_HEADS * GLA_DV
IN_SIZES = (W_A, W_A, W_A, W_BQ, W_BKV, W_BKV, W_CK, W_CK, W_CV, W_CV, GLA_RANK, GLA_RANK, D_MODEL, D_MODEL, D_MODEL)
D_IN = sum(IN_SIZES)

kernel_name = 'hybrid_diffusion_trunk_step'


def rms_norm(x, g):
    xf = x.astype(jnp.float32)
    y = xf * lax.rsqrt(jnp.mean(xf * xf, axis=-1, keepdims=True) + EPS)
    return (y * g.astype(jnp.float32)).astype(x.dtype)


def axial_rope(T):
    t = np.arange(T)
    n_freq = HEAD_DIM // 4
    inv_freq = ROPE_THETA ** (-np.arange(n_freq) / n_freq)
    ang = np.concatenate([(t // GRID_W)[:, None] * inv_freq, (t % GRID_W)[:, None] * inv_freq], axis=-1)
    return jnp.asarray(np.cos(ang), jnp.float32), jnp.asarray(np.sin(ang), jnp.float32)


def apply_rope(x, cos, sin):
    half = x.shape[-1] // 2
    x1 = x[..., :half].astype(jnp.float32)
    x2 = x[..., half:].astype(jnp.float32)
    c = cos[None, :, None, :]
    s = sin[None, :, None, :]
    return jnp.concatenate([x1 * c - x2 * s, x1 * s + x2 * c], axis=-1).astype(x.dtype)


def block_attention(q, k, v):
    B, Tq, Hq, hd = q.shape
    Hkv = k.shape[2]
    G = Hq // Hkv
    nb = Tq // Q_BLOCK
    qb = jnp.moveaxis(q.reshape(B, nb, Q_BLOCK, Hkv, G, hd), 1, 0)
    scale = hd ** -0.5

    def one_block(qi):
        s = jnp.einsum('bqhgd,bkhd->bhgqk', qi, k, preferred_element_type=jnp.float32) * scale
        pr = jax.nn.softmax(s, axis=-1).astype(v.dtype)
        return jnp.einsum('bhgqk,bkhd->bqhgd', pr, v)

    o = lax.map(one_block, qb)
    return jnp.moveaxis(o, 0, 1).reshape(B, Tq, Hq * hd)


def neighborhood_attention(q, k, v, k_ctx, v_ctx, rpb):
    B, T, H, hd = q.shape
    rows = T // GRID_W
    kh = min(NA_KH, rows)
    ncb = GRID_W // NA_QCOLS
    r = np.arange(rows)
    key_rows = np.clip(r - kh // 2, 0, rows - kh)[:, None] + np.arange(kh)[None, :]
    qcols = np.arange(GRID_W).reshape(ncb, NA_QCOLS)
    key_cols = np.clip(qcols[:, 0] - NA_KW // 2, 0, GRID_W - NA_KCOLS)[:, None] + np.arange(NA_KCOLS)[None, :]
    win0 = np.clip(qcols - NA_KW // 2, 0, GRID_W - NA_KW)
    in_win = (key_cols[:, None, :] >= win0[:, :, None]) & (key_cols[:, None, :] < win0[:, :, None] + NA_KW)
    dr_idx = key_rows - r[:, None] + NA_KH - 1
    dc_idx = np.clip(key_cols[:, None, :] - qcols[:, :, None] + NA_KW - 1, 0, 2 * NA_KW - 2)
    bias = rpb[:, dr_idx[:, :, None, None, None], dc_idx[None, None]]
    bias = jnp.where(in_win[None, None, None], bias.astype(jnp.float32), NEG_INF)
    bias = bias.transpose(1, 3, 0, 4, 2, 5)

    scale = hd ** -0.5
    qg = q.reshape(B, rows, ncb, NA_QCOLS, H, hd)
    kgrid = k.reshape(B, rows, GRID_W, H, hd)
    vgrid = v.reshape(B, rows, GRID_W, H, hd)
    gr = key_rows[:, :, None, None]
    gc = key_cols[None, None]
    k_blk = kgrid[:, gr, gc]
    v_blk = vgrid[:, gr, gc]
    s_loc = jnp.einsum('brnqhd,brknchd->brnhqkc', qg, k_blk, preferred_element_type=jnp.float32) * scale + bias[None]
    s_ctx = jnp.einsum('brnqhd,blhd->brnhql', qg, k_ctx, preferred_element_type=jnp.float32) * scale
    n_loc = kh * NA_KCOLS
    s = jnp.concatenate([s_loc.reshape(s_loc.shape[:5] + (n_loc,)), s_ctx], axis=-1)
    pr = jax.nn.softmax(s, axis=-1).astype(v.dtype)
    p_loc = pr[..., :n_loc].reshape(s_loc.shape)
    p_ctx = pr[..., n_loc:]
    o = (jnp.einsum('brnhqkc,brknchd->brnqhd', p_loc, v_blk)
         + jnp.einsum('brnhql,blhd->brnqhd', p_ctx, v_ctx))
    return o.reshape(B, T, H * hd)


def gla_scan(q, k, v, log_a, s0):
    B, H, T, dk = q.shape
    dv = v.shape[-1]
    C = GLA_CHUNK
    n = T // C
    f32 = jnp.float32
    q = q.astype(f32).reshape(B, H, n, C, dk)
    k = k.astype(f32).reshape(B, H, n, C, dk)
    v = v.astype(f32).reshape(B, H, n, C, dv)
    b = jnp.cumsum(log_a.astype(f32).reshape(B, H, n, C, dk), axis=3)
    b_last = b[:, :, :, -1:, :]
    causal = np.tril(np.ones((C, C), dtype=bool))[:, :, None]
    decay = jnp.exp(jnp.where(causal, b[:, :, :, :, None, :] - b[:, :, :, None, :, :], -jnp.inf))
    att = jnp.einsum('bhntd,bhnsd,bhntsd->bhnts', q, k, decay)
    o_intra = jnp.einsum('bhnts,bhnsv->bhntv', att, v)
    kv = jnp.einsum('bhncd,bhncv->nbhdv', k * jnp.exp(b_last - b), v)
    chunk_decay = jnp.moveaxis(jnp.exp(b_last[:, :, :, 0, :]), 2, 0)

    def step(state, inp):
        dec, kv_n = inp
        return dec[..., None] * state + kv_n, state

    s_final, s_prev = lax.scan(step, s0.astype(f32), (chunk_decay, kv))
    o_inter = jnp.einsum('bhncd,nbhdv->bhncv', q * jnp.exp(b), s_prev)
    return (o_intra + o_inter).reshape(B, H, T, dv), s_final


def bidir_gla(q, k, v, la_f, la_b, s0_f, s0_b):
    o_f, s_f = gla_scan(q, k, v, la_f, s0_f)
    flip = lambda t: jnp.flip(t, axis=2)
    o_b, s_b = gla_scan(flip(q), flip(k), flip(v), flip(la_b), s0_b)
    return o_f + flip(o_b), s_f, s_b


def mixer_sublayer(h, p, ctx):
    B, T, _ = h.shape
    f32 = jnp.float32
    splits = np.cumsum(IN_SIZES)[:-1].tolist()
    (qa, ka, va, qb, kb, vb, qc, kc, vc, rc, zf, zb, ga, gb, gc) = jnp.split(h @ p['w_in'], splits, axis=-1)
    qa = rms_norm(qa.reshape(B, T, NA_HEADS, HEAD_DIM), p['na_q_norm'])
    ka = rms_norm(ka.reshape(B, T, NA_HEADS, HEAD_DIM), p['na_k_norm'])
    va = va.reshape(B, T, NA_HEADS, HEAD_DIM)
    qb = rms_norm(qb.reshape(B, T, GQA_Q_HEADS, HEAD_DIM), p['gqa_q_norm'])
    kb = rms_norm(kb.reshape(B, T, GQA_KV_HEADS, HEAD_DIM), p['gqa_k_norm'])
    vb = vb.reshape(B, T, GQA_KV_HEADS, HEAD_DIM)
    to_heads = lambda t, d: t.reshape(B, T, GLA_HEADS, d).transpose(0, 2, 1, 3)
    qc = to_heads(qc, GLA_DK) * GLA_DK ** -0.5
    kc = to_heads(kc, GLA_DK)
    vc = to_heads(vc, GLA_DV)
    la_f = to_heads(jax.nn.log_sigmoid((zf @ p['gla_wg2'][0] + p['gla_bg'][0]).astype(f32)) / GLA_TAU, GLA_DK)
    la_b = to_heads(jax.nn.log_sigmoid((zb @ p['gla_wg2'][1] + p['gla_bg'][1]).astype(f32)) / GLA_TAU, GLA_DK)
    if ctx is None:
        oa = block_attention(qa, ka, va)
        ob = block_attention(qb, kb, vb)
        s0 = jnp.zeros((B, GLA_HEADS, GLA_DK, GLA_DV), f32)
        oc, s_f, s_b = bidir_gla(qc, kc, vc, la_f, la_b, s0, s0)
        new_ctx = (ka, va, kb, vb, s_f.astype(h.dtype), s_b.astype(h.dtype))
    else:
        ka_c, va_c, kb_c, vb_c, s0_f, s0_b = ctx
        oa = neighborhood_attention(qa, ka, va, ka_c, va_c, p['na_rpb'])
        cos, sin = axial_rope(T)
        ob = block_attention(apply_rope(qb, cos, sin),
                             jnp.concatenate([apply_rope(kb, cos, sin), kb_c], axis=1),
                             jnp.concatenate([vb, vb_c], axis=1))
        oc, _, _ = bidir_gla(qc, kc, vc, la_f, la_b, s0_f, s0_b)
        new_ctx = None
    oc = rms_norm(oc.transpose(0, 2, 1, 3), p['gla_out_norm']).reshape(B, T, W_CV).astype(h.dtype) * jax.nn.silu(rc)
    merged = (jax.nn.sigmoid(ga) * (oa @ p['w_branch_a'])
              + jax.nn.sigmoid(gb) * (ob @ p['w_branch_b'])
              + jax.nn.sigmoid(gc) * (oc @ p['w_branch_c']))
    return merged @ p['w_out'], new_ctx


def conv_ffn(h, p):
    u = h @ p['ffn_w_up']
    T = u.shape[1]
    pad = CONV_W // 2
    up = jnp.pad(u, ((0, 0), (pad, pad), (0, 0)))
    w = p['ffn_conv_w']
    acc = p['ffn_conv_b'] + up[:, 0:T] * w[0]
    for j in range(1, CONV_W):
        acc = acc + up[:, j:j + T] * w[j]
    a, g = jnp.split(acc, 2, axis=-1)
    return (a * jax.nn.silu(g)) @ p['ffn_w_down']


def trunk_layer(x, cond, p, ctx):
    mod = jax.nn.silu(cond) @ p['w_mod'] + p['b_mod']
    sh1, sc1, g1, sh2, sc2, g2 = [m[:, None, :] for m in jnp.split(mod, 6, axis=-1)]
    h = rms_norm(x, p['g_attn']) * (1 + sc1) + sh1
    a, new_ctx = mixer_sublayer(h, p, ctx)
    x = x + g1 * a
    h = rms_norm(x, p['g_ffn']) * (1 + sc2) + sh2
    x = x + g2 * conv_ffn(h, p)
    return x, new_ctx


def setup_inputs(seed: int = 0) -> dict:
    key = jax.random.key(seed)
    ks = iter(jax.random.split(key, 40))
    nrm = lambda shape, s: jax.random.normal(next(ks), shape, jnp.float32) * s
    L = DEPTH
    D = D_MODEL
    return {
        'x_prompt': nrm((BATCH, SEQ, D), 1.0),
        'x_sample': nrm((DEC_BATCH, DEC_SEQ, D), 1.0),
        'cache_na_k': nrm((DEC_BATCH, L, PAST_LEN, NA_HEADS, HEAD_DIM), 1.0),
        'cache_na_v': nrm((DEC_BATCH, L, PAST_LEN, NA_HEADS, HEAD_DIM), 1.0),
        'cache_gqa_k': nrm((DEC_BATCH, L, PAST_LEN, GQA_KV_HEADS, HEAD_DIM), 1.0),
        'cache_gqa_v': nrm((DEC_BATCH, L, PAST_LEN, GQA_KV_HEADS, HEAD_DIM), 1.0),
        'state_gla_fwd': nrm((DEC_BATCH, L, GLA_HEADS, GLA_DK, GLA_DV), 1.0),
        'state_gla_bwd': nrm((DEC_BATCH, L, GLA_HEADS, GLA_DK, GLA_DV), 1.0),
        'c': nrm((DEC_BATCH, D), 1.0),
        'c_ctx': nrm((D,), 1.0),
        'w_mod': nrm((L, D, 6 * D), D ** -0.5),
        'b_mod': nrm((L, 6 * D), 0.02),
        'g_attn': 1.0 + nrm((L, D), 0.01),
        'g_ffn': 1.0 + nrm((L, D), 0.01),
        'w_in': nrm((L, D, D_IN), D ** -0.5),
        'na_q_norm': 1.0 + nrm((L, HEAD_DIM), 0.01),
        'na_k_norm': 1.0 + nrm((L, HEAD_DIM), 0.01),
        'na_rpb': nrm((L, NA_HEADS, 2 * NA_KH - 1, 2 * NA_KW - 1), 0.1),
        'gqa_q_norm': 1.0 + nrm((L, HEAD_DIM), 0.01),
        'gqa_k_norm': 1.0 + nrm((L, HEAD_DIM), 0.01),
        'gla_wg2': nrm((L, 2, GLA_RANK, W_CK), GLA_RANK ** -0.5),
        'gla_bg': nrm((L, 2, W_CK), 0.1),
        'gla_out_norm': 1.0 + nrm((L, GLA_DV), 0.01),
        'w_branch_a': nrm((L, W_A, D), W_A ** -0.5),
        'w_branch_b': nrm((L, W_BQ, D), W_BQ ** -0.5),
        'w_branch_c': nrm((L, W_CV, D), W_CV ** -0.5),
        'w_out': nrm((L, D, D), D ** -0.5),
        'ffn_w_up': nrm((L, D, 2 * D_FF), D ** -0.5),
        'ffn_conv_w': nrm((L, CONV_W, 2 * D_FF), CONV_W ** -0.5),
        'ffn_conv_b': nrm((L, 2 * D_FF), 0.01),
        'ffn_w_down': nrm((L, D_FF, D), D_FF ** -0.5),
    }


def reference(x_prompt, x_sample, cache_na_k, cache_na_v, cache_gqa_k, cache_gqa_v, state_gla_fwd, state_gla_bwd,
              c, c_ctx, w_mod, b_mod, g_attn, g_ffn, w_in, na_q_norm, na_k_norm, na_rpb, gqa_q_norm, gqa_k_norm,
              gla_wg2, gla_bg, gla_out_norm, w_branch_a, w_branch_b, w_branch_c, w_out,
              ffn_w_up, ffn_conv_w, ffn_conv_b, ffn_w_down):
    stacked = dict(w_mod=w_mod, b_mod=b_mod, g_attn=g_attn, g_ffn=g_ffn, w_in=w_in,
                   na_q_norm=na_q_norm, na_k_norm=na_k_norm, na_rpb=na_rpb,
                   gqa_q_norm=gqa_q_norm, gqa_k_norm=gqa_k_norm,
                   gla_wg2=gla_wg2, gla_bg=gla_bg, gla_out_norm=gla_out_norm,
                   w_branch_a=w_branch_a, w_branch_b=w_branch_b, w_branch_c=w_branch_c, w_out=w_out,
                   ffn_w_up=ffn_w_up, ffn_conv_w=ffn_conv_w, ffn_conv_b=ffn_conv_b, ffn_w_down=ffn_w_down)
    ctx_cond = c_ctx[None, :]
    y_prompt = x_prompt
    y_sample = x_sample
    new = ([], [], [], [], [], [])
    for l in range(DEPTH):
        p = {name: arr[l] for name, arr in stacked.items()}
        y_prompt, ctx_l = trunk_layer(y_prompt, ctx_cond, p, None)
        for lst, t in zip(new, ctx_l):
            lst.append(t)
        cache_l = (cache_na_k[:, l], cache_na_v[:, l], cache_gqa_k[:, l], cache_gqa_v[:, l],
                   state_gla_fwd[:, l], state_gla_bwd[:, l])
        y_sample, _ = trunk_layer(y_sample, c, p, cache_l)
    new_na_k, new_na_v, new_gqa_k, new_gqa_v, new_gla_fwd, new_gla_bwd = [jnp.stack(t, axis=1) for t in new]
    return (y_prompt, y_sample, new_na_k, new_na_v, new_gqa_k, new_gqa_v, new_gla_fwd, new_gla_bwd)
```

```cpp
#include <hip/hip_runtime.h>
#include <hip/hip_cooperative_groups.h>
#include <cstdio>
namespace cg = cooperative_groups;

typedef unsigned short u16;
typedef __attribute__((ext_vector_type(8))) short bf16x8;
typedef __attribute__((ext_vector_type(4))) float f32x4;
typedef __attribute__((ext_vector_type(4))) unsigned u32x4;
typedef __attribute__((ext_vector_type(2))) unsigned u32x2;

#define DEV __device__ __forceinline__

#define NTOK 16384
#define DM 1024
#define NP 5888
#define DIN 5664
#define DFF 2816
#define LDH 1088
#define LDW1 1088
#define LDACT 2880
#define LDVS 4160
#define C_QA 0
#define C_KA 256
#define C_VA 512
#define C_QB 768
#define C_KB 1280
#define C_VB 1408
#define C_QC 1536
#define C_KC 1792
#define C_VC 2048
#define C_RC 2304
#define C_ZF 2560
#define C_GA 2592
#define C_GB 3616
#define C_GC 4640

constexpr size_t OFF_WT_IN  = 0;
constexpr size_t OFF_WT_A   = OFF_WT_IN  + (size_t)NP * LDW1 * 2;
constexpr size_t OFF_WT_B   = OFF_WT_A   + (size_t)1024 * 256 * 2;
constexpr size_t OFF_WT_C   = OFF_WT_B   + (size_t)1024 * 512 * 2;
constexpr size_t OFF_WT_OUT = OFF_WT_C   + (size_t)1024 * 256 * 2;
constexpr size_t OFF_WT_UP  = OFF_WT_OUT + (size_t)1024 * LDW1 * 2;
constexpr size_t OFF_WT_DN  = OFF_WT_UP  + (size_t)5632 * LDW1 * 2;
constexpr size_t OFF_MOD    = OFF_WT_DN  + (size_t)1024 * LDACT * 2;
constexpr size_t OFF_CKA    = OFF_MOD    + (size_t)4 * 3 * 6144 * 4;
constexpr size_t OFF_CVTA   = OFF_CKA    + (size_t)1048576 * 2;
constexpr size_t OFF_CKB    = OFF_CVTA   + (size_t)1048576 * 2;
constexpr size_t OFF_CVTB   = OFF_CKB    + (size_t)524288 * 2;
constexpr size_t OFF_H      = OFF_CVTB   + (size_t)524288 * 2;
constexpr size_t OFF_PROJ   = OFF_H      + (size_t)NTOK * LDH * 2;
constexpr size_t OFF_ACT    = OFF_PROJ   + (size_t)NTOK * NP * 2;
constexpr size_t OFF_KVF    = OFF_ACT;
constexpr size_t OFF_KVB    = OFF_KVF    + (size_t)1024 * 4096 * 4;
constexpr size_t OFF_CUMF   = OFF_KVB    + (size_t)1024 * 4096 * 4;
constexpr size_t OFF_CUMB   = OFF_CUMF   + (size_t)NTOK * 256 * 4;
constexpr size_t OFF_DF     = OFF_CUMB   + (size_t)NTOK * 256 * 4;
constexpr size_t OFF_DB     = OFF_DF     + (size_t)1024 * 64 * 4;
constexpr size_t OFF_OA     = OFF_ACT    + (size_t)NTOK * LDACT * 2;
constexpr size_t OFF_OB     = OFF_OA     + (size_t)NTOK * 256 * 2;
constexpr size_t OFF_OC     = OFF_OB     + (size_t)NTOK * 512 * 2;
constexpr size_t OFF_VTA_P  = OFF_OC     + (size_t)NTOK * 256 * 2;
constexpr size_t OFF_VTA_S  = OFF_VTA_P  + (size_t)32 * 4 * 64 * 256 * 2;
constexpr size_t OFF_VTB_P  = OFF_VTA_S  + (size_t)2 * 4 * 64 * LDVS * 2;
constexpr size_t OFF_VTB_S  = OFF_VTB_P  + (size_t)32 * 2 * 64 * 256 * 2;
constexpr size_t OFF_BAR    = OFF_VTB_S  + (size_t)2 * 2 * 64 * LDVS * 2;
constexpr size_t OFF_XB     = OFF_BAR    + 16384;
constexpr size_t WS_END     = OFF_XB     + (size_t)NTOK * 1024 * 2;

constexpr size_t OUT_NAK = 16777216, OUT_NAV = 25165824, OUT_GQK = 33554432, OUT_GQV = 37748736,
                 OUT_GLF = 41943040, OUT_GLB = 44040192;

#define LDS_BYTES (2 * 73728 + 16)

struct Params {
  const float* in[31];
  float* out;
  unsigned char* ws;
};

#if defined(__HIP_DEVICE_COMPILE__)
#define AS4 __attribute__((address_space(4)))
#else
#define AS4
#endif
typedef const AS4 Params* PP;
DEV PP load_params() {
#if defined(__HIP_DEVICE_COMPILE__)
  PP k = (PP)__builtin_amdgcn_kernarg_segment_ptr();
  asm volatile("" : "+s"(k));
  return k;
#else
  return nullptr;
#endif
}

DEV u16 f2bf(float f) { return __builtin_bit_cast(u16, (__bf16)f); }
DEV float bf2f(u16 h) { return __uint_as_float(((unsigned)h) << 16); }
typedef __bf16 bf16x2_t __attribute__((ext_vector_type(2)));
typedef float float2_t __attribute__((ext_vector_type(2)));
DEV unsigned pack2(float a, float b) {
  float2_t f = {a, b};
  bf16x2_t h = __builtin_convertvector(f, bf16x2_t);
  return __builtin_bit_cast(unsigned, h);
}
DEV float lo2f(unsigned u) { return __uint_as_float(u << 16); }
DEV float hi2f(unsigned u) { return __uint_as_float(u & 0xffff0000u); }
DEV float silu_f(float x) { return x / (1.f + __expf(-x)); }
DEV float sigm_f(float x) { return 1.f / (1.f + __expf(-x)); }
DEV float logsig_f(float x) { return fminf(x, 0.f) - __logf(1.f + __expf(-fabsf(x))); }
DEV float wave_sum(float v) {
#pragma unroll
  for (int o = 32; o; o >>= 1) v += __shfl_xor(v, o);
  return v;
}
DEV int otid() { int t = threadIdx.x & 255; asm volatile("" : "+v"(t)); return t; }
DEV int ftid() { int t = threadIdx.x; asm volatile("" : "+v"(t)); return t; }
DEV int vhalf() { return __builtin_amdgcn_readfirstlane((int)(threadIdx.x >> 8)); }
#define VB (blockIdx.x * 2 + vhalf())
#define VG (gridDim.x * 2)
#define HALF_LDS 73728
DEV void lds_barrier() { asm volatile("s_waitcnt lgkmcnt(0)\n\ts_barrier" ::: "memory"); }

#define XB_TMO      128
#define XB_XCNT(j)  (256  + 64 * (j))
#define XB_XSUB(j)  (1280 + 64 * (j))
#define XB_XGEN(j)  (2304 + 64 * (j))
#define XB_TOP      3328
#define XB_TOPGEN   3392
#define XCD_BAR_WORDS 3456
#define XB_SPIN_CAP (1u << 22)
#define LAS __attribute__((address_space(3)))
DEV unsigned xb_ld(unsigned* p) { return __hip_atomic_load(p, __ATOMIC_RELAXED, __HIP_MEMORY_SCOPE_AGENT); }
DEV unsigned xb_add(unsigned* p, unsigned v) { return __hip_atomic_fetch_add(p, v, __ATOMIC_RELAXED, __HIP_MEMORY_SCOPE_AGENT); }
DEV unsigned xb_xcc_id() { return (unsigned)__builtin_amdgcn_s_getreg((3 << 11) | 20) & 0xFu; }
#define XB_SPIN(cond, bar) do { unsigned _sp = 0; while (cond) { __builtin_amdgcn_s_sleep(1); \
    if ((++_sp & 255u) == 0u) { if (xb_ld(&(bar)[XB_TMO])) break; if (_sp > XB_SPIN_CAP) { atomicAdd(&(bar)[XB_TMO], 1u); break; } } } } while (0)
struct XcdBarrier { unsigned* bar; unsigned x; volatile LAS unsigned* st; };
DEV XcdBarrier xcd_barrier_post(unsigned* bar, volatile LAS unsigned* st) {
  XcdBarrier b; b.bar = bar; b.x = xb_xcc_id(); b.st = st;
  if (threadIdx.x == 0) (void)xb_add(&bar[XB_XCNT(b.x)], 1u);
  return b;
}
DEV void xcd_barrier_complete(unsigned* bar, unsigned x, unsigned& nloc, unsigned& nx) {
  const unsigned G = gridDim.x * gridDim.y * gridDim.z;
  unsigned sum, cnt, mine, sp = 0u;
  for (;;) {
    sum = 0u; cnt = 0u; mine = 0u;
#pragma unroll
    for (unsigned j = 0; j < 16; ++j) { const unsigned c = xb_ld(&bar[XB_XCNT(j)]); sum += c; cnt += (c > 0u) ? 1u : 0u; mine = (j == x) ? c : mine; }
    if (sum == G) break;
    __builtin_amdgcn_s_sleep(1);
    if ((++sp & 255u) == 0u) { if (xb_ld(&bar[XB_TMO])) break; if (sp > XB_SPIN_CAP) { atomicAdd(&bar[XB_TMO], 1u); break; } }
  }
  nloc = mine > 0u ? mine : 1u; nx = cnt > 0u ? cnt : 1u;
}
DEV void xcd_barrier(const XcdBarrier& b) {
  asm volatile("s_waitcnt vmcnt(0)" ::: "memory");
  __syncthreads();
  if (threadIdx.x == 0) {
    unsigned* bar = b.bar;
    __builtin_amdgcn_s_waitcnt(0);
    unsigned nloc = b.st[0], nx = b.st[1];
    if (nloc == 0u) { xcd_barrier_complete(bar, b.x, nloc, nx); b.st[0] = nloc; b.st[1] = nx; }
    const unsigned old = xb_add(&bar[XB_XSUB(b.x)], 1u);
    const unsigned gen = old / nloc;
    if (old + 1u == (gen + 1u) * nloc) {
      __builtin_amdgcn_fence(__ATOMIC_RELEASE, "agent");
      asm volatile("s_waitcnt vmcnt(0)" ::: "memory");
      const unsigned og = xb_add(&bar[XB_TOP], 1u);
      const unsigned tg = og / nx;
      if (og + 1u == (tg + 1u) * nx) xb_add(&bar[XB_TOPGEN], 1u);
      else XB_SPIN(xb_ld(&bar[XB_TOPGEN]) == tg, bar);
      __builtin_amdgcn_fence(__ATOMIC_ACQUIRE, "agent");
      xb_add(&bar[XB_XGEN(b.x)], 1u);
      asm volatile("s_waitcnt vmcnt(0)" ::: "memory");
    } else {
      XB_SPIN(xb_ld(&bar[XB_XGEN(b.x)]) == gen, bar);
      __builtin_amdgcn_fence(__ATOMIC_ACQUIRE, "agent");
      asm volatile("s_waitcnt vmcnt(0)" ::: "memory");
    }
  }
  __syncthreads();
}

DEV int cond_of(int row) { return row < 8192 ? 0 : 1 + ((row - 8192) >> 12); }

DEV void phase_mod(PP p, float* smf) {
  const int tid = otid();
  const float* c = p->in[8];
  const float* cctx = p->in[9];
  float* MOD = (float*)(p->ws + OFF_MOD);
  __syncthreads();
  for (int i = tid; i < 3072; i += 256) {
    int ci = i >> 10, k = i & 1023;
    float v = ci == 0 ? cctx[k] : c[(ci - 1) * 1024 + k];
    smf[i] = silu_f(v);
  }
  __syncthreads();
  float* part = smf + 3072;
  for (int it = VB; it < 4 * 96; it += VG) {
    const int l = it / 96, n0 = (it % 96) * 64;
    const int col = tid & 63, kg = tid >> 6;
    const float* W = p->in[10] + ((size_t)l * 1024 + kg * 256) * 6144 + n0 + col;
    float a0 = 0.f, a1 = 0.f, a2 = 0.f;
#pragma unroll 8
    for (int k = 0; k < 256; ++k) {
      float w = W[(size_t)k * 6144];
      int kk = kg * 256 + k;
      a0 += smf[kk] * w; a1 += smf[1024 + kk] * w; a2 += smf[2048 + kk] * w;
    }
    part[(kg * 3 + 0) * 64 + col] = a0;
    part[(kg * 3 + 1) * 64 + col] = a1;
    part[(kg * 3 + 2) * 64 + col] = a2;
    __syncthreads();
    if (tid < 192) {
      int ci = tid >> 6, cc = tid & 63;
      float s = part[(0 * 3 + ci) * 64 + cc] + part[(1 * 3 + ci) * 64 + cc] + part[(2 * 3 + ci) * 64 + cc] +
                part[(3 * 3 + ci) * 64 + cc] + p->in[11][l * 6144 + n0 + cc];
      MOD[(l * 3 + ci) * 6144 + n0 + cc] = s;
    }
    __syncthreads();
  }
}

DEV void phase_cache(PP p) {
  u16* CKA = (u16*)(p->ws + OFF_CKA);
  u16* CVTA = (u16*)(p->ws + OFF_CVTA);
  u16* CKB = (u16*)(p->ws + OFF_CKB);
  u16* CVTB = (u16*)(p->ws + OFF_CVTB);
  const int gtid = VB * 256 + otid(), gsz = VG * 256;
  for (int i = gtid; i < 1048576; i += gsz) {
    {
      int d = i & 63, pp = (i >> 6) & 511, h = (i >> 15) & 3, b = (i >> 17) & 1, l = i >> 18;
      CKA[i] = f2bf(p->in[2][((((size_t)b * 4 + l) * 512 + pp) * 4 + h) * 64 + d]);
    }
    {
      int pp = i & 511, d = (i >> 9) & 63, h = (i >> 15) & 3, b = (i >> 17) & 1, l = i >> 18;
      CVTA[i] = f2bf(p->in[3][((((size_t)b * 4 + l) * 512 + pp) * 4 + h) * 64 + d]);
    }
  }
  for (int i = gtid; i < 524288; i += gsz) {
    {
      int d = i & 63, pp = (i >> 6) & 511, h = (i >> 15) & 1, b = (i >> 16) & 1, l = i >> 17;
      CKB[i] = f2bf(p->in[4][((((size_t)b * 4 + l) * 512 + pp) * 2 + h) * 64 + d]);
    }
    {
      int pp = i & 511, d = (i >> 9) & 63, h = (i >> 15) & 1, b = (i >> 16) & 1, l = i >> 17;
      CVTB[i] = f2bf(p->in[5][((((size_t)b * 4 + l) * 512 + pp) * 2 + h) * 64 + d]);
    }
  }
}

DEV void transpose_convert(const float* __restrict__ W, int K, int N, u16* __restrict__ WT, int Npad, int ldw,
                                  float* tile, int& base, bool cmap = false) {
  const int G = VG, tid = otid();
  const int nkt = K >> 6, nnt = Npad >> 6, ntiles = nkt * nnt;
  const int start = (int)(((long)VB - (base % G) + G) % G);
  const int col = tid & 63, r = tid >> 6;
  float v[16];
#define TC_LOAD(T)                                                                      \
  {                                                                                     \
    const int _k0 = ((T) % nkt) * 64, _n0 = ((T) / nkt) * 64;                           \
    const int _np = _n0 + col;                                                          \
    const int _sc = cmap ? ((_np >> 8) * 128 + (_np & 127) + ((_np & 128) ? 2816 : 0)) : _np; \
    const bool _ok = _sc < N;                                                           \
    const float* _src = W + (size_t)(_k0 + r) * N + (_ok ? _sc : 0);                    \
    _Pragma("unroll") for (int i = 0; i < 16; ++i) { float _x = _src[(size_t)(4 * i) * N]; v[i] = _ok ? _x : 0.f; } \
  }
  if (start < ntiles) TC_LOAD(start);
  for (int t = start; t < ntiles; t += G) {
    const int kt = t % nkt, nt = t / nkt;
    const int k0 = kt * 64, n0 = nt * 64;
    __syncthreads();
#pragma unroll
    for (int i = 0; i < 16; ++i) tile[(r + 4 * i) * 65 + col] = v[i];
    if (t + G < ntiles) TC_LOAD(t + G);
    __syncthreads();
    {
      const int n = tid >> 2, kc = (tid & 3) * 16;
      unsigned o[8];
#pragma unroll
      for (int j = 0; j < 8; ++j) o[j] = pack2(tile[(kc + 2 * j) * 65 + n], tile[(kc + 2 * j + 1) * 65 + n]);
      u32x4* dst = (u32x4*)(WT + (size_t)(n0 + n) * ldw + k0 + kc);
      dst[0] = u32x4{o[0], o[1], o[2], o[3]};
      dst[1] = u32x4{o[4], o[5], o[6], o[7]};
    }
  }
#undef TC_LOAD
  base += ntiles;
}

DEV void phase_convert_weights(PP p, int l, float* smf) {
  int base = 0;
  transpose_convert(p->in[14] + (size_t)l * 1024 * DIN, 1024, DIN, (u16*)(p->ws + OFF_WT_IN), NP, LDW1, smf, base);
  transpose_convert(p->in[27] + (size_t)l * 1024 * 5632, 1024, 5632, (u16*)(p->ws + OFF_WT_UP), 5632, LDW1, smf, base, true);
  transpose_convert(p->in[30] + (size_t)l * 2816 * 1024, 2816, 1024, (u16*)(p->ws + OFF_WT_DN), 1024, LDACT, smf, base);
  transpose_convert(p->in[26] + (size_t)l * 1024 * 1024, 1024, 1024, (u16*)(p->ws + OFF_WT_OUT), 1024, LDW1, smf, base);
  transpose_convert(p->in[23] + (size_t)l * 256 * 1024, 256, 1024, (u16*)(p->ws + OFF_WT_A), 1024, 256, smf, base);
  transpose_convert(p->in[24] + (size_t)l * 512 * 1024, 512, 1024, (u16*)(p->ws + OFF_WT_B), 1024, 512, smf, base);
  transpose_convert(p->in[25] + (size_t)l * 256 * 1024, 256, 1024, (u16*)(p->ws + OFF_WT_C), 1024, 256, smf, base);
}

DEV void phase_norm(PP p, int l, int which) {
  const int tid0 = otid();
  const int lane = tid0 & 63, w = tid0 >> 6;
  const float* g = p->in[which ? 13 : 12] + l * 1024;
  const float* MOD = (const float*)(p->ws + OFF_MOD);
  u16* H = (u16*)(p->ws + OFF_H);
  u16* XB = (u16*)(p->ws + OFF_XB);
  const bool first = (l == 0 && which == 0);
  for (int grp = VB * 4 + w; grp < NTOK / 4; grp += VG * 4) {
    const int row0 = grp * 4;
    const float* md = MOD + (l * 3 + cond_of(row0)) * 6144 + which * 3072;
    f32x4 v[4][4];
    if (first) {
      const float* xr = row0 < 8192 ? p->in[0] + (size_t)row0 * 1024 : p->in[1] + (size_t)(row0 - 8192) * 1024;
#pragma unroll
      for (int r = 0; r < 4; ++r)
#pragma unroll
        for (int i = 0; i < 4; ++i) v[r][i] = *(const f32x4*)(xr + (size_t)r * 1024 + i * 256 + lane * 4);
    } else {
#pragma unroll
      for (int r = 0; r < 4; ++r)
#pragma unroll
        for (int i = 0; i < 4; ++i) {
          const u32x2 q = *(const u32x2*)(XB + (size_t)(row0 + r) * 1024 + i * 256 + lane * 4);
          v[r][i] = f32x4{lo2f(q.x), hi2f(q.x), lo2f(q.y), hi2f(q.y)};
        }
    }
    float rstd[4];
#pragma unroll
    for (int r = 0; r < 4; ++r) {
      float ss = 0.f;
#pragma unroll
      for (int i = 0; i < 4; ++i) ss += v[r][i][0] * v[r][i][0] + v[r][i][1] * v[r][i][1] + v[r][i][2] * v[r][i][2] + v[r][i][3] * v[r][i][3];
      ss = wave_sum(ss);
      rstd[r] = rsqrtf(ss * (1.f / 1024.f) + 1e-6f);
    }
#pragma unroll
    for (int i = 0; i < 4; ++i) {
      const int col = i * 256 + lane * 4;
      const f32x4 gg = *(const f32x4*)(g + col);
      const f32x4 sh = *(const f32x4*)(md + col);
      const f32x4 sc = *(const f32x4*)(md + 1024 + col);
      const f32x4 gs = gg * (sc + 1.f);
#pragma unroll
      for (int r = 0; r < 4; ++r) {
        const f32x4 hv = v[r][i] * rstd[r] * gs + sh;
        const u32x2 o = {pack2(hv[0], hv[1]), pack2(hv[2], hv[3])};
        *(u32x2*)(H + (size_t)(row0 + r) * LDH + col) = o;
        if (first) { const u32x2 xo = {pack2(v[r][i][0], v[r][i][1]), pack2(v[r][i][2], v[r][i][3])}; *(u32x2*)(XB + (size_t)(row0 + r) * 1024 + col) = xo; }
      }
    }
  }
}

#define LDT 72
template <int NI>
DEV void gemm_kloop(const u16* __restrict__ A, int lda, const u16* __restrict__ B, int ldb, int K,
                    f32x4 (&acc)[8][NI], u16* sm, int tid, bool preloaded = false) {
  const int lane = tid & 63, w = tid >> 6, wr = w >> 2, wc = w & 3;
  const int lr = tid >> 3, lc = (tid & 7) * 8;
  const int l15 = lane & 15, quad = lane >> 4;
  constexpr int GL = 64;
  constexpr int BUFSZ = (256 + 64 * NI) * GL;
  const int lcx = ((tid & 7) ^ ((lr >> 1) & 7)) * 8;
  const unsigned oa = lr * lda + lcx, ob = lr * ldb + lcx;
  char* const lw = (char*)sm + tid * 16;
  const int pc0 = quad ^ (l15 >> 1);
  const u16* const fra = sm + (wr * 128 + l15) * GL;
  const u16* const frb = sm + 256 * GL + (wc * 16 * NI + l15) * GL;
#define G_ISSUE(BUF, KT)                                                                     \
  {                                                                                          \
    _Pragma("unroll") for (int i = 0; i < 4; ++i)                                            \
      __builtin_amdgcn_global_load_lds((const unsigned*)(A + (oa + (unsigned)(64 * i) * lda + (KT) * 64)),            \
                                       (unsigned*)(lw + (BUF) * (BUFSZ * 2) + i * 8192), 16, 0, 0);                   \
    _Pragma("unroll") for (int i = 0; i < NI; ++i)                                           \
      __builtin_amdgcn_global_load_lds((const unsigned*)(B + (ob + (unsigned)(64 * i) * ldb + (KT) * 64)),            \
                                       (unsigned*)(lw + (BUF) * (BUFSZ * 2) + 256 * 128 + i * 8192), 16, 0, 0);       \
  }
#define G_WAIT asm volatile("s_waitcnt vmcnt(0)" ::: "memory")
#define SB_ __builtin_amdgcn_sched_barrier(0)
#define LDA_(dst, BUF, ks, h) _Pragma("unroll") for (int i = 0; i < 4; ++i) dst[i] = *(const bf16x8*)(fra + (BUF) * BUFSZ + (((h) * 4 + i) * 16) * GL + ((pc0 ^ ((ks) * 4)) * 8))
#define LDB_(dst, BUF, ks) _Pragma("unroll") for (int i = 0; i < NI; ++i) dst[i] = *(const bf16x8*)(frb + (BUF) * BUFSZ + (i * 16) * GL + ((pc0 ^ ((ks) * 4)) * 8))
#define MM_(a, b, h) _Pragma("unroll") for (int i = 0; i < 4; ++i) _Pragma("unroll") for (int ni = 0; ni < NI; ++ni) \
    acc[(h) * 4 + i][ni] = __builtin_amdgcn_mfma_f32_16x16x32_bf16(b[ni], a[i], acc[(h) * 4 + i][ni], 0, 0, 0)
#define G_COMPUTE(BUF)                                                                       \
  {                                                                                          \
    bf16x8 a0[4], a1[4], b0[NI];                                                             \
    LDA_(a0, BUF, 0, 0); LDB_(b0, BUF, 0); LDA_(a1, BUF, 0, 1); SB_;                         \
    MM_(a0, b0, 0); SB_;                                                                     \
    LDA_(a0, BUF, 1, 0); SB_;                                                                \
    MM_(a1, b0, 1); SB_;                                                                     \
    LDB_(b0, BUF, 1); LDA_(a1, BUF, 1, 1); SB_;                                              \
    MM_(a0, b0, 0); SB_;                                                                     \
    MM_(a1, b0, 1); SB_;                                                                     \
  }
  const int nk = K >> 6;
  if (!preloaded) {
    lds_barrier();
    G_ISSUE(0, 0);
  }
  G_WAIT;
  lds_barrier();
  for (int kt = 0; kt < nk; kt += 2) {
    G_ISSUE(1, kt + 1);
    G_COMPUTE(0);
    G_WAIT;
    lds_barrier();
    G_ISSUE(0, min(kt + 2, nk - 1));
    G_COMPUTE(1);
    G_WAIT;
    lds_barrier();
  }
#undef G_ISSUE
#undef G_WAIT
#undef G_COMPUTE
#undef SB_
#undef LDA_
#undef LDB_
#undef MM_
}

template <int NI>
DEV void gemm_issue_first(const u16* __restrict__ A, int lda, const u16* __restrict__ B, int ldb, u16* sm, int tid) {
  const int lr = tid >> 3;
  const int lcx = ((tid & 7) ^ ((lr >> 1) & 7)) * 8;
  const unsigned oa = lr * lda + lcx, ob = lr * ldb + lcx;
  char* const lw = (char*)sm + tid * 16;
#pragma unroll
  for (int i = 0; i < 4; ++i)
    __builtin_amdgcn_global_load_lds((const unsigned*)(A + (oa + (unsigned)(64 * i) * lda)), (unsigned*)(lw + i * 8192), 16, 0, 0);
#pragma unroll
  for (int i = 0; i < NI; ++i)
    __builtin_amdgcn_global_load_lds((const unsigned*)(B + (ob + (unsigned)(64 * i) * ldb)), (unsigned*)(lw + 256 * 128 + i * 8192), 16, 0, 0);
}

DEV int tile_for(int it, int nM, int nN, int& tm, int& tn, int PNreq = 0) {
  const int G = gridDim.x;
  if ((G & 63) == 0) {
    const int nslots = G >> 3;
    const int PN = (PNreq > 0 && nslots % PNreq == 0) ? PNreq : (nslots >> 3);
    const int PM = nslots / PN;
    const int xcd = blockIdx.x & 7, slot = blockIdx.x >> 3;
    const int dm = slot / PN, dn = slot % PN;
    const int npn = (nN + PN - 1) / PN, npm = (nM + PM - 1) / PM;
    const int per = (npm * npn + 7) >> 3;
    const int pch = xcd * per + it;
    if (it >= per || pch >= npm * npn) return -1;
    tm = (pch / npn) * PM + dm;
    tn = (pch % npn) * PN + dn;
    return (tm < nM && tn < nN) ? 1 : 0;
  } else {
    int t = blockIdx.x + it * G;
    if (t >= nM * nN) return -1;
    tm = t / nN; tn = t % nN;
    return 1;
  }
}

DEV void phase_gemm_store(const u16* A, int lda, const u16* Bt, int ldb, int K, int nN, u16* C, int ldc, u16* sm, PP p, int l, bool fuse_post) {
  const int tid = ftid();
  const int lane = tid & 63, w = tid >> 6, wr = w >> 2, wc = w & 3, l15 = lane & 15, quad = lane >> 4;
  bool pre = false;
  for (int it = 0;; ++it) {
    int tm, tn;
    int r = tile_for(it, 64, nN, tm, tn, 8);
    if (r < 0) break;
    if (r == 0) { pre = false; continue; }
    int ntm = 0, ntn = 0;
    const bool has_next = tile_for(it + 1, 64, nN, ntm, ntn, 8) == 1;
    f32x4 acc[8][4];
#pragma unroll
    for (int i = 0; i < 8; ++i)
#pragma unroll
      for (int j = 0; j < 4; ++j) acc[i][j] = f32x4{0.f, 0.f, 0.f, 0.f};
    gemm_kloop<4>(A + (size_t)tm * 256 * lda, lda, Bt + (size_t)tn * 256 * ldb, ldb, K, acc, sm, tid, pre);
    if (fuse_post && tn < 6) {
      int tn_ = tn, tm_ = tm, wc_ = wc, quad_ = quad, l15_ = l15, wr_ = wr;
      asm volatile("" : "+s"(tn_), "+s"(tm_));
      asm volatile("" : "+v"(wc_), "+v"(quad_), "+v"(l15_), "+v"(wr_));
      const int tn = tn_, tm = tm_, wc = __builtin_amdgcn_readfirstlane(wc_), quad = quad_, l15 = l15_, wr = __builtin_amdgcn_readfirstlane(wr_);
      const bool sample = tm >= 32;
      const bool is_v = (tn == 2) || (tn == 5 && wc >= 2);
      const bool rope = sample && (tn == 3 || tn == 4 || (tn == 5 && wc < 2));
      const float* wn = p->in[tn == 0 ? 15 : tn == 1 ? 16 : tn == 5 ? 19 : 18] + l * 64 + quad * 4;
      float* outb = nullptr; int ostride = 0;
      if (!sample) {
        if (tn == 1) { outb = p->out + OUT_NAK + wc * 64; ostride = 256; }
        else if (tn == 2) { outb = p->out + OUT_NAV + wc * 64; ostride = 256; }
        else if (tn == 5) { outb = p->out + (wc < 2 ? OUT_GQK : OUT_GQV) + (wc & 1) * 64; ostride = 128; }
      }
      float invf[4];
#pragma unroll
      for (int j = 0; j < 4; ++j) invf[j] = exp2f(-(float)(quad * 4 + j) * 0.83048202372184058696f);
#pragma unroll
      for (int mi = 0; mi < 8; ++mi) {
        const int m = tm * 256 + wr * 128 + mi * 16 + l15;
        if (!is_v) {
          float ss = 0.f;
#pragma unroll
          for (int ni = 0; ni < 4; ++ni)
#pragma unroll
            for (int j = 0; j < 4; ++j) ss += acc[mi][ni][j] * acc[mi][ni][j];
          ss += __shfl_xor(ss, 16);
          ss += __shfl_xor(ss, 32);
          const float rstd = rsqrtf(ss * (1.f / 64.f) + 1e-6f);
#pragma unroll
          for (int ni = 0; ni < 4; ++ni) {
            const f32x4 wv = *(const f32x4*)(wn + ni * 16);
            acc[mi][ni] = acc[mi][ni] * rstd * wv;
          }
          if (rope) {
            const int t = (m - 8192) & 4095;
            const float gr = (float)(t >> 6), gc = (float)(t & 63);
#pragma unroll
            for (int j = 0; j < 4; ++j) {
              const float aA = gr * invf[j], aB = gc * invf[j];
              const float cA = __cosf(aA), sA = __sinf(aA), cB = __cosf(aB), sB = __sinf(aB);
              const float x1 = acc[mi][0][j], x2 = acc[mi][2][j];
              acc[mi][0][j] = x1 * cA - x2 * sA; acc[mi][2][j] = x1 * sA + x2 * cA;
              const float y1 = acc[mi][1][j], y2 = acc[mi][3][j];
              acc[mi][1][j] = y1 * cB - y2 * sB; acc[mi][3][j] = y1 * sB + y2 * cB;
            }
          }
        }
        if (outb) {
          const int t = m & 255;
          float* orow = outb + ((size_t)(tm * 4 + l) * 256 + t) * ostride + quad * 4;
#pragma unroll
          for (int ni = 0; ni < 4; ++ni) *(f32x4*)(orow + ni * 16) = acc[mi][ni];
        }
        __builtin_amdgcn_sched_barrier(0);
      }
    }
    {
      unsigned char* cl = (unsigned char*)sm;
      int t2 = tid;
      asm volatile("" : "+v"(t2));
      const int wr = t2 >> 8, wc = (t2 >> 6) & 3, l15 = t2 & 15, quad = (t2 >> 4) & 3;
#pragma unroll
      for (int mi = 0; mi < 8; ++mi) {
        const int row = wr * 128 + mi * 16 + l15;
#pragma unroll
        for (int ni = 0; ni < 4; ++ni) {
          const int col = wc * 64 + ni * 16 + quad * 4;
          u32x2 o = {pack2(acc[mi][ni][0], acc[mi][ni][1]), pack2(acc[mi][ni][2], acc[mi][ni][3])};
          *(u32x2*)(cl + row * 520 + col * 2) = o;
        }
      }
      lds_barrier();
      const int rr = t2 >> 5, cc = t2 & 31;
      const bool do_pf = has_next && !(fuse_post && (tn == 2 || tn == 5));
#pragma unroll
      for (int q = 0; q < 8; ++q) {
        const int row = q * 16 + rr;
        const u32x2 lo = *(const u32x2*)(cl + row * 520 + cc * 16);
        const u32x2 hi = *(const u32x2*)(cl + row * 520 + cc * 16 + 8);
        const u32x4 o = {lo.x, lo.y, hi.x, hi.y};
        *(u32x4*)(C + (size_t)(tm * 256 + row) * ldc + tn * 256 + cc * 8) = o;
      }
      if (do_pf) {
        lds_barrier();
        gemm_issue_first<4>(A + (size_t)ntm * 256 * lda, lda, Bt + (size_t)ntn * 256 * ldb, ldb, sm, tid);
      }
      pre = do_pf;
#pragma unroll
      for (int q = 8; q < 16; ++q) {
        const int row = q * 16 + rr;
        const u32x2 lo = *(const u32x2*)(cl + row * 520 + cc * 16);
        const u32x2 hi = *(const u32x2*)(cl + row * 520 + cc * 16 + 8);
        const u32x4 o = {lo.x, lo.y, hi.x, hi.y};
        *(u32x4*)(C + (size_t)(tm * 256 + row) * ldc + tn * 256 + cc * 8) = o;
      }
      if (fuse_post && (tn == 2 || tn == 5)) {
        const bool sample = tm >= 32;
        const int ncol = tn == 2 ? 256 : 128, cbase = tn == 2 ? 0 : 128;
        const int T = sample ? LDVS : 256;
        const int sb = (tm - 32) >> 4, t0 = sample ? ((tm - 32) & 15) * 256 : 0;
        u16* vt;
        if (tn == 2) vt = (u16*)(p->ws + (sample ? OFF_VTA_S : OFF_VTA_P)) + (size_t)(sample ? sb : tm) * 4 * 64 * T;
        else         vt = (u16*)(p->ws + (sample ? OFF_VTB_S : OFF_VTB_P)) + (size_t)(sample ? sb : tm) * 2 * 64 * T;
        const int nunits = ncol * 32;
        for (int u = t2; u < nunits; u += 512) {
          const int cidx = u & (ncol - 1), chunk = u / ncol;
          const unsigned char* src = cl + (chunk * 8) * 520 + (cbase + cidx) * 2;
          unsigned o[4];
#pragma unroll
          for (int j = 0; j < 4; ++j) {
            const unsigned a = *(const u16*)(src + (2 * j) * 520);
            const unsigned b2 = *(const u16*)(src + (2 * j + 1) * 520);
            o[j] = a | (b2 << 16);
          }
          *(u32x4*)(vt + (size_t)cidx * T + t0 + chunk * 8) = u32x4{o[0], o[1], o[2], o[3]};
        }
      }
    }
  }
}

DEV void conv_rows(const unsigned char* cl, int row_base, int t2, int tm, int tn, u16* ACT, const float* cw, const float* cb) {
  const int cg8 = (t2 & 15) * 8, rb = row_base + (t2 >> 4) * 4;
  const int ca = tn * 128 + cg8;
  float wa[3][8], wg[3][8], ba[8], bg[8];
#pragma unroll
  for (int j = 0; j < 3; ++j) {
    const f32x4 t0 = *(const f32x4*)(cw + j * 5632 + ca), t1 = *(const f32x4*)(cw + j * 5632 + ca + 4);
    const f32x4 t2v = *(const f32x4*)(cw + j * 5632 + 2816 + ca), t3 = *(const f32x4*)(cw + j * 5632 + 2816 + ca + 4);
#pragma unroll
    for (int q = 0; q < 4; ++q) { wa[j][q] = t0[q]; wa[j][4 + q] = t1[q]; wg[j][q] = t2v[q]; wg[j][4 + q] = t3[q]; }
  }
  {
    const f32x4 t0 = *(const f32x4*)(cb + ca), t1 = *(const f32x4*)(cb + ca + 4);
    const f32x4 t2v = *(const f32x4*)(cb + 2816 + ca), t3 = *(const f32x4*)(cb + 2816 + ca + 4);
#pragma unroll
    for (int q = 0; q < 4; ++q) { ba[q] = t0[q]; ba[4 + q] = t1[q]; bg[q] = t2v[q]; bg[4 + q] = t3[q]; }
  }
  u32x4 ra[6], rg[6];
  const u32x4 zero4 = {0u, 0u, 0u, 0u};
#pragma unroll
  for (int i = 0; i < 6; ++i) {
    const int row = rb - 1 + i;
    const bool ok = row >= 0 && row < 256;
    const unsigned char* src = cl + (ok ? row : 0) * 520 + cg8 * 2;
    const u32x2 a0 = *(const u32x2*)(src), a1 = *(const u32x2*)(src + 8);
    const u32x2 g0 = *(const u32x2*)(src + 256), g1 = *(const u32x2*)(src + 264);
    ra[i] = ok ? u32x4{a0.x, a0.y, a1.x, a1.y} : zero4;
    rg[i] = ok ? u32x4{g0.x, g0.y, g1.x, g1.y} : zero4;
  }
#pragma unroll
  for (int i = 0; i < 4; ++i) {
    u32x4 o;
#pragma unroll
    for (int q = 0; q < 4; ++q) {
      const float a0 = ba[2 * q] + lo2f(ra[i][q]) * wa[0][2 * q] + lo2f(ra[i + 1][q]) * wa[1][2 * q] + lo2f(ra[i + 2][q]) * wa[2][2 * q];
      const float a1 = ba[2 * q + 1] + hi2f(ra[i][q]) * wa[0][2 * q + 1] + hi2f(ra[i + 1][q]) * wa[1][2 * q + 1] + hi2f(ra[i + 2][q]) * wa[2][2 * q + 1];
      const float g0 = bg[2 * q] + lo2f(rg[i][q]) * wg[0][2 * q] + lo2f(rg[i + 1][q]) * wg[1][2 * q] + lo2f(rg[i + 2][q]) * wg[2][2 * q];
      const float g1 = bg[2 * q + 1] + hi2f(rg[i][q]) * wg[0][2 * q + 1] + hi2f(rg[i + 1][q]) * wg[1][2 * q + 1] + hi2f(rg[i + 2][q]) * wg[2][2 * q + 1];
      o[q] = pack2(a0 * silu_f(g0), a1 * silu_f(g1));
    }
    *(u32x4*)(ACT + (size_t)(tm * 256 + rb + i) * LDACT + ca) = o;
  }
}

DEV void phase_gemm_up_conv(PP p, int l, u16* sm) {
  const int tid = ftid();
  const u16* A = (const u16*)(p->ws + OFF_H);
  const u16* Bt = (const u16*)(p->ws + OFF_WT_UP);
  u16* ACT = (u16*)(p->ws + OFF_ACT);
  u16* HALO = (u16*)(p->ws + OFF_OA);
  const float* cw = p->in[28] + (size_t)l * 3 * 5632;
  const float* cb = p->in[29] + (size_t)l * 5632;
  bool pre = false;
  for (int it = 0;; ++it) {
    int tm, tn;
    int r = tile_for(it, 64, 22, tm, tn, 8);
    if (r < 0) break;
    if (r == 0) { pre = false; continue; }
    int ntm = 0, ntn = 0;
    const bool has_next = tile_for(it + 1, 64, 22, ntm, ntn, 8) == 1;
    f32x4 acc[8][4];
#pragma unroll
    for (int i = 0; i < 8; ++i)
#pragma unroll
      for (int j = 0; j < 4; ++j) acc[i][j] = f32x4{0.f, 0.f, 0.f, 0.f};
    gemm_kloop<4>(A + (size_t)tm * 256 * LDH, LDH, Bt + (size_t)tn * 256 * LDW1, LDW1, 1024, acc, sm, tid, pre);
    {
      unsigned char* cl = (unsigned char*)sm;
      int t2 = tid;
      asm volatile("" : "+v"(t2));
      const int wr = t2 >> 8, wc = (t2 >> 6) & 3, l15 = t2 & 15, quad = (t2 >> 4) & 3;
#pragma unroll
      for (int mi = 0; mi < 8; ++mi) {
        const int row = wr * 128 + mi * 16 + l15;
#pragma unroll
        for (int ni = 0; ni < 4; ++ni) {
          const int col = wc * 64 + ni * 16 + quad * 4;
          u32x2 o = {pack2(acc[mi][ni][0], acc[mi][ni][1]), pack2(acc[mi][ni][2], acc[mi][ni][3])};
          *(u32x2*)(cl + row * 520 + col * 2) = o;
        }
      }
      lds_barrier();
      if (t2 < 128) {
        const int hr = t2 >> 5, chunk = t2 & 31;
        const int row = hr < 2 ? hr : 252 + hr;
        const unsigned char* src = cl + row * 520 + chunk * 16;
        const u32x2 lo = *(const u32x2*)(src), hi = *(const u32x2*)(src + 8);
        const int dcol = chunk < 16 ? tn * 128 + chunk * 8 : 2816 + tn * 128 + (chunk - 16) * 8;
        *(u32x4*)(HALO + ((size_t)(tm * 4 + hr)) * 5632 + dcol) = u32x4{lo.x, lo.y, hi.x, hi.y};
      }
      conv_rows(cl, 0, t2, tm, tn, ACT, cw, cb);
      if (has_next) {
        lds_barrier();
        gemm_issue_first<4>(A + (size_t)ntm * 256 * LDH, LDH, Bt + (size_t)ntn * 256 * LDW1, LDW1, sm, tid);
      }
      pre = has_next;
      conv_rows(cl, 128, t2, tm, tn, ACT, cw, cb);
    }
  }
}

DEV void conv_fix_rows(PP p, int l, int tm, int t2) {
  if (tm < 32) return;
  const int ts = (tm - 32) & 15;
  const u16* HALO = (const u16*)(p->ws + OFF_OA);
  u16* ACT = (u16*)(p->ws + OFF_ACT);
  const float* cw = p->in[28] + (size_t)l * 3 * 5632;
  const float* cb = p->in[29] + (size_t)l * 5632;
  for (int u = t2; u < 704; u += 512) {
    const int last = u >= 352, c0 = (last ? u - 352 : u) * 8;
    if (last ? (ts == 15) : (ts == 0)) continue;
    const u16* hp = last ? HALO + (size_t)(tm * 4 + 2) * 5632 : HALO + (size_t)((tm - 1) * 4 + 3) * 5632;
    const u16* hc = last ? HALO + (size_t)(tm * 4 + 3) * 5632 : HALO + (size_t)(tm * 4 + 0) * 5632;
    const u16* hn = last ? HALO + (size_t)((tm + 1) * 4 + 0) * 5632 : HALO + (size_t)(tm * 4 + 1) * 5632;
    const u32x4 pa = *(const u32x4*)(hp + c0), pg = *(const u32x4*)(hp + 2816 + c0);
    const u32x4 ca = *(const u32x4*)(hc + c0), cgv = *(const u32x4*)(hc + 2816 + c0);
    const u32x4 na = *(const u32x4*)(hn + c0), ng = *(const u32x4*)(hn + 2816 + c0);
    u32x4 o;
#pragma unroll
    for (int q = 0; q < 4; ++q) {
      const int c = c0 + 2 * q;
      const float a0 = cb[c] + lo2f(pa[q]) * cw[c] + lo2f(ca[q]) * cw[5632 + c] + lo2f(na[q]) * cw[2 * 5632 + c];
      const float a1 = cb[c + 1] + hi2f(pa[q]) * cw[c + 1] + hi2f(ca[q]) * cw[5632 + c + 1] + hi2f(na[q]) * cw[2 * 5632 + c + 1];
      const float g0 = cb[2816 + c] + lo2f(pg[q]) * cw[2816 + c] + lo2f(cgv[q]) * cw[5632 + 2816 + c] + lo2f(ng[q]) * cw[2 * 5632 + 2816 + c];
      const float g1 = cb[2816 + c + 1] + hi2f(pg[q]) * cw[2816 + c + 1] + hi2f(cgv[q]) * cw[5632 + 2816 + c + 1] + hi2f(ng[q]) * cw[2 * 5632 + 2816 + c + 1];
      o[q] = pack2(a0 * silu_f(g0), a1 * silu_f(g1));
    }
    *(u32x4*)(ACT + (size_t)(tm * 256 + (last ? 255 : 0)) * LDACT + c0) = o;
  }
}

DEV void phase_gemm_resid(const u16* A, int lda, const u16* Bt, int ldb, int K, u16* XB, const float* gate_l, u16* sm, float* final_out,
                          PP pfix = nullptr, int lfix = 0) {
  const int tid = ftid();
  const int lane = tid & 63, w = tid >> 6, wr = w >> 2, wc = w & 3, l15 = lane & 15, quad = lane >> 4;
  for (int it = 0;; ++it) {
    int tm, tn;
    int r = tile_for(it, 64, 4, tm, tn);
    if (r < 0) break;
    if (r == 0) continue;
    f32x4 acc[8][4];
#pragma unroll
    for (int i = 0; i < 8; ++i)
#pragma unroll
      for (int j = 0; j < 4; ++j) acc[i][j] = f32x4{0.f, 0.f, 0.f, 0.f};
    if (pfix) {
      conv_fix_rows(pfix, lfix, tm, tid);
      asm volatile("s_waitcnt vmcnt(0)" ::: "memory");
      __syncthreads();
    }
    gemm_kloop<4>(A + (size_t)tm * 256 * lda, lda, Bt + (size_t)tn * 256 * ldb, ldb, K, acc, sm, tid);
    const float* gt = gate_l + cond_of(tm * 256) * 6144;
#pragma unroll
    for (int ni = 0; ni < 4; ++ni) {
      const int n = tn * 256 + wc * 64 + ni * 16 + quad * 4;
      const f32x4 gg = *(const f32x4*)(gt + n);
#pragma unroll
      for (int mi = 0; mi < 8; ++mi) {
        const int m = tm * 256 + wr * 128 + mi * 16 + l15;
        u32x2* xp = (u32x2*)(XB + (size_t)m * 1024 + n);
        const u32x2 xq = *xp;
        f32x4 x = {lo2f(xq.x), hi2f(xq.x), lo2f(xq.y), hi2f(xq.y)};
        x += gg * acc[mi][ni];
        if (final_out) *(f32x4*)(final_out + (size_t)m * 1024 + n) = x;
        else { const u32x2 xo = {pack2(x[0], x[1]), pack2(x[2], x[3])}; *xp = xo; }
      }
    }
  }
}

DEV void phase_gemm_merge(PP p, u16* sm) {
  const int tid = ftid();
  const int lane = tid & 63, w = tid >> 6, wr = w >> 2, wc = w & 3, l15 = lane & 15, quad = lane >> 4;
  const u16* PROJ = (const u16*)(p->ws + OFF_PROJ);
  u16* MG = (u16*)(p->ws + OFF_H);
  for (int it = 0;; ++it) {
    int tm, tn;
    int r = tile_for(it, 64, 8, tm, tn);
    if (r < 0) break;
    if (r == 0) continue;
    f32x4 tot[8][2];
#pragma unroll
    for (int i = 0; i < 8; ++i)
#pragma unroll
      for (int j = 0; j < 2; ++j) tot[i][j] = f32x4{0.f, 0.f, 0.f, 0.f};
#pragma unroll 1
    for (int br = 0; br < 3; ++br) {
      const u16* A = (const u16*)(p->ws + (br == 0 ? OFF_OA : br == 1 ? OFF_OB : OFF_OC));
      const u16* Bt = (const u16*)(p->ws + (br == 0 ? OFF_WT_A : br == 1 ? OFF_WT_B : OFF_WT_C));
      const int K = br == 1 ? 512 : 256;
      const int gcol = br == 0 ? C_GA : br == 1 ? C_GB : C_GC;
      f32x4 acc[8][2];
#pragma unroll
      for (int i = 0; i < 8; ++i)
#pragma unroll
        for (int j = 0; j < 2; ++j) acc[i][j] = f32x4{0.f, 0.f, 0.f, 0.f};
      gemm_kloop<2>(A + (size_t)tm * 256 * K, K, Bt + (size_t)tn * 128 * K, K, K, acc, sm, tid);
#pragma unroll
      for (int mi = 0; mi < 8; ++mi) {
        const int m = tm * 256 + wr * 128 + mi * 16 + l15;
#pragma unroll
        for (int ni = 0; ni < 2; ++ni) {
          const int n = tn * 128 + wc * 32 + ni * 16 + quad * 4;
          const u32x2 gq = *(const u32x2*)(PROJ + (size_t)m * NP + gcol + n);
          tot[mi][ni][0] += sigm_f(lo2f(gq.x)) * acc[mi][ni][0];
          tot[mi][ni][1] += sigm_f(hi2f(gq.x)) * acc[mi][ni][1];
          tot[mi][ni][2] += sigm_f(lo2f(gq.y)) * acc[mi][ni][2];
          tot[mi][ni][3] += sigm_f(hi2f(gq.y)) * acc[mi][ni][3];
        }
      }
    }
#pragma unroll
    for (int mi = 0; mi < 8; ++mi) {
      const int m = tm * 256 + wr * 128 + mi * 16 + l15;
#pragma unroll
      for (int ni = 0; ni < 2; ++ni) {
        const int n = tn * 128 + wc * 32 + ni * 16 + quad * 4;
        u32x2 o = {pack2(tot[mi][ni][0], tot[mi][ni][1]), pack2(tot[mi][ni][2], tot[mi][ni][3])};
        *(u32x2*)(MG + (size_t)m * LDH + n) = o;
      }
    }
  }
}

DEV void gla_g1_item(PP p, int l, int tb, int h, float* sm) {
  float* ZF = sm;
  float* ZB = sm + 1024;
  float* LF = sm + 2048;
  float* LB = LF + 4096;
  float* TOT = LB + 4096;
  float* OFS = TOT + 512;
  u16* KFT = (u16*)(sm + 11392);
  u16* KBT = KFT + 64 * 72;
  u16* VT = KBT + 64 * 72;
  const int tid = otid();
  const int r0 = tb * 64;
  const u16* PROJ = (const u16*)(p->ws + OFF_PROJ);
  float* CUMF = (float*)(p->ws + OFF_CUMF);
  float* CUMB = (float*)(p->ws + OFF_CUMB);
  float wf[16], wb[16];
  float kreg[16];
  const int gd = tid & 63;
  const float* wg = p->in[20] + (size_t)l * 2 * 16 * 256 + h * 64 + gd;
#pragma unroll
  for (int r = 0; r < 16; ++r) { wf[r] = wg[r * 256]; wb[r] = wg[16 * 256 + r * 256]; }
  const float bf = p->in[21][l * 512 + h * 64 + gd], bb = p->in[21][l * 512 + 256 + h * 64 + gd];
#pragma unroll
  for (int j = 0; j < 16; ++j) {
    const int t = (tid >> 6) + 4 * j;
    kreg[j] = bf2f(PROJ[(size_t)(r0 + t) * NP + C_KC + h * 64 + gd]);
  }
  __syncthreads();
  {
    const int t = tid >> 2, c8 = (tid & 3) * 8;
    const u32x4 zq = *(const u32x4*)(PROJ + (size_t)(r0 + t) * NP + C_ZF + c8);
    float* zd = (c8 < 16) ? (ZF + t * 16 + c8) : (ZB + t * 16 + c8 - 16);
    *(f32x4*)(zd) = f32x4{lo2f(zq[0]), hi2f(zq[0]), lo2f(zq[1]), hi2f(zq[1])};
    *(f32x4*)(zd + 4) = f32x4{lo2f(zq[2]), hi2f(zq[2]), lo2f(zq[3]), hi2f(zq[3])};
  }
#pragma unroll
  for (int k = 0; k < 4; ++k) {
    const int u = tid + 256 * k, t = u >> 4, v4 = (u & 15) * 4;
    const u32x2 q = *(const u32x2*)(PROJ + (size_t)(r0 + t) * NP + C_VC + h * 64 + v4);
    VT[(v4 + 0) * 72 + t] = (u16)(q.x & 0xffffu);
    VT[(v4 + 1) * 72 + t] = (u16)(q.x >> 16);
    VT[(v4 + 2) * 72 + t] = (u16)(q.y & 0xffffu);
    VT[(v4 + 3) * 72 + t] = (u16)(q.y >> 16);
  }
  __syncthreads();
  {
    const int d = tid & 63, tg = tid >> 6;
    float accF = 0.f, accB = 0.f;
    for (int i = 0; i < 16; ++i) {
      const int tf = tg * 16 + i, tbk = tg * 16 + 15 - i;
      float af = bf, ab = bb;
#pragma unroll
      for (int r = 0; r < 16; ++r) { af += ZF[tf * 16 + r] * wf[r]; ab += ZB[tbk * 16 + r] * wb[r]; }
      accF += logsig_f(af) * (1.f / 16.f);
      accB += logsig_f(ab) * (1.f / 16.f);
      LF[tf * 64 + d] = accF;
      LB[tbk * 64 + d] = accB;
    }
    TOT[tg * 64 + d] = accF;
    TOT[256 + tg * 64 + d] = accB;
  }
  __syncthreads();
  {
    const int d = tid & 63, tg = tid >> 6;
    float oF = 0.f, oB = 0.f, tF = 0.f, tB = 0.f;
#pragma unroll
    for (int g = 0; g < 4; ++g) {
      const float a = TOT[g * 64 + d], b = TOT[256 + g * 64 + d];
      tF += a; tB += b;
      oF += (g < tg) ? a : 0.f;
      oB += (g > tg) ? b : 0.f;
    }
    OFS[tg * 64 + d] = oF;
    OFS[256 + tg * 64 + d] = oB;
    if (tg == 0) { OFS[512 + d] = tF; OFS[576 + d] = tB; }
  }
  __syncthreads();
  const int gi = tb * 4 + h;
  const float totF = OFS[512 + (tid & 63)], totB = OFS[576 + (tid & 63)];
  if (tid < 64) {
    ((float*)(p->ws + OFF_DF))[gi * 64 + tid] = __expf(totF);
    ((float*)(p->ws + OFF_DB))[gi * 64 + tid] = __expf(totB);
  }
#pragma unroll
  for (int j = 0; j < 16; ++j) {
    const int i = tid + 256 * j;
    const int t = i >> 6, d = i & 63;
    const float cf = LF[i] + OFS[(t >> 4) * 64 + d];
    const float cb = LB[i] + OFS[256 + (t >> 4) * 64 + d];
    CUMF[(size_t)(r0 + t) * 256 + h * 64 + d] = cf;
    CUMB[(size_t)(r0 + t) * 256 + h * 64 + d] = cb;
    const float k = kreg[j];
    KFT[d * 72 + t] = f2bf(k * __expf(totF - cf));
    KBT[d * 72 + t] = f2bf(k * __expf(totB - cb));
  }
  __syncthreads();
  {
    const int lane = tid & 63, w = tid >> 6, quad = lane >> 4, l15 = lane & 15;
    const bf16x8 kf0 = *(const bf16x8*)(KFT + (16 * w + l15) * 72 + quad * 8);
    const bf16x8 kf1 = *(const bf16x8*)(KFT + (16 * w + l15) * 72 + 32 + quad * 8);
    const bf16x8 kb0 = *(const bf16x8*)(KBT + (16 * w + l15) * 72 + quad * 8);
    const bf16x8 kb1 = *(const bf16x8*)(KBT + (16 * w + l15) * 72 + 32 + quad * 8);
    u16* KVF = (u16*)(p->ws + OFF_KVF) + (size_t)gi * 4096;
    u16* KVB = (u16*)(p->ws + OFF_KVB) + (size_t)gi * 4096;
    const int d = 16 * w + l15;
#pragma unroll
    for (int vt = 0; vt < 4; ++vt) {
      const bf16x8 v0 = *(const bf16x8*)(VT + (vt * 16 + l15) * 72 + quad * 8);
      const bf16x8 v1 = *(const bf16x8*)(VT + (vt * 16 + l15) * 72 + 32 + quad * 8);
      f32x4 af = f32x4{0.f, 0.f, 0.f, 0.f}, ab = f32x4{0.f, 0.f, 0.f, 0.f};
      af = __builtin_amdgcn_mfma_f32_16x16x32_bf16(v0, kf0, af, 0, 0, 0);
      af = __builtin_amdgcn_mfma_f32_16x16x32_bf16(v1, kf1, af, 0, 0, 0);
      ab = __builtin_amdgcn_mfma_f32_16x16x32_bf16(v0, kb0, ab, 0, 0, 0);
      ab = __builtin_amdgcn_mfma_f32_16x16x32_bf16(v1, kb1, ab, 0, 0, 0);
      const u32x2 of = {pack2(af[0], af[1]), pack2(af[2], af[3])};
      const u32x2 ob = {pack2(ab[0], ab[1]), pack2(ab[2], ab[3])};
      *(u32x2*)(KVF + d * 64 + vt * 16 + quad * 4) = of;
      *(u32x2*)(KVB + d * 64 + vt * 16 + quad * 4) = ob;
    }
  }
}

template <int CH>
DEV void gla_g2_scan(u16* KV, const float* DC, int tb0, int N, int h, int dir, int e, int d, f32x4& S) {
  for (int m0 = 0; m0 < N; m0 += CH) {
    u32x2 kv[CH]; float dc[CH];
#pragma unroll
    for (int j = 0; j < CH; ++j) {
      const int m = dir ? (N - 1 - (m0 + j)) : (m0 + j);
      const int gi = (tb0 + m) * 4 + h;
      kv[j] = *(const u32x2*)(KV + (size_t)gi * 4096 + e);
      dc[j] = DC[gi * 64 + d];
    }
#pragma unroll
    for (int j = 0; j < CH; ++j) {
      const int m = dir ? (N - 1 - (m0 + j)) : (m0 + j);
      const int gi = (tb0 + m) * 4 + h;
      const u32x2 so = {pack2(S[0], S[1]), pack2(S[2], S[3])};
      *(u32x2*)(KV + (size_t)gi * 4096 + e) = so;
      const f32x4 kf = {lo2f(kv[j].x), hi2f(kv[j].x), lo2f(kv[j].y), hi2f(kv[j].y)};
      S = S * dc[j] + kf;
    }
  }
}
DEV void gla_g2_item(PP p, int l, int item) {
  const int tid = otid();
  const int quarter = item & 3, dir = (item >> 2) & 1, h = (item >> 3) & 3, seq = item >> 5;
  const int e = quarter * 1024 + tid * 4, d = e >> 6;
  u16* KV = (u16*)(p->ws + (dir ? OFF_KVB : OFF_KVF));
  const float* DC = (const float*)(p->ws + (dir ? OFF_DB : OFF_DF));
  f32x4 S = {0.f, 0.f, 0.f, 0.f};
  if (seq < 32) {
    gla_g2_scan<4>(KV, DC, seq * 4, 4, h, dir, e, d, S);
    *(f32x4*)(p->out + (dir ? OUT_GLB : OUT_GLF) + ((size_t)(seq * 4 + l) * 4 + h) * 4096 + e) = S;
  } else {
    const int b = seq - 32;
    S = *(const f32x4*)(p->in[dir ? 7 : 6] + ((size_t)(b * 4 + l) * 4 + h) * 4096 + e);
    gla_g2_scan<32>(KV, DC, 128 + b * 64, 64, h, dir, e, d, S);
  }
}

#define GT 72
DEV void gla_g3_item(PP p, int l, int tb, int h, u16* sm) {
  u16* QH = sm;
  u16* KH = sm + 64 * GT;
  u16* VT = KH + 64 * GT;
  u16* ST = VT + 64 * GT;
  const int tid = otid(), lane = tid & 63, w = tid >> 6, quad = lane >> 4, l15 = lane & 15;
  const int r0 = tb * 64, gi = tb * 4 + h;
  const u16* PROJ = (const u16*)(p->ws + OFF_PROJ);
  u32x2 gv[4], gq[4], gk[4], gsF[4], gsB[4];
  f32x4 gcF[4], gcB[4];
  {
    const float* CF = (const float*)(p->ws + OFF_CUMF);
    const float* CB = (const float*)(p->ws + OFF_CUMB);
    const u16* SF = (const u16*)(p->ws + OFF_KVF) + (size_t)gi * 4096;
    const u16* SB = (const u16*)(p->ws + OFF_KVB) + (size_t)gi * 4096;
#pragma unroll
    for (int k = 0; k < 4; ++k) {
      const int u = tid + 256 * k, t = u >> 4, c4 = (u & 15) * 4;
      const u16* prow = PROJ + (size_t)(r0 + t) * NP + h * 64 + c4;
      gv[k] = *(const u32x2*)(prow + C_VC);
      gq[k] = *(const u32x2*)(prow + C_QC);
      gk[k] = *(const u32x2*)(prow + C_KC);
      gcF[k] = *(const f32x4*)(CF + (size_t)(r0 + t) * 256 + h * 64 + c4);
      gcB[k] = *(const f32x4*)(CB + (size_t)(r0 + t) * 256 + h * 64 + c4);
      gsF[k] = *(const u32x2*)(SF + t * 64 + c4);
      gsB[k] = *(const u32x2*)(SB + t * 64 + c4);
    }
  }
  u32x2 grq[4];
  f32x4 gg4[4];
  {
    const int erow = r0 + 16 * w + l15;
    const float* gn = p->in[22] + l * 64;
#pragma unroll
    for (int vt = 0; vt < 4; ++vt) {
      const int v = vt * 16 + quad * 4;
      gg4[vt] = *(const f32x4*)(gn + v);
      grq[vt] = *(const u32x2*)(PROJ + (size_t)erow * NP + C_RC + h * 64 + v);
    }
  }
  __syncthreads();
#pragma unroll
  for (int k = 0; k < 4; ++k) {
    const int u = tid + 256 * k, t = u >> 4, v4 = (u & 15) * 4;
    const u32x2 q = gv[k];
    VT[(v4 + 0) * GT + t] = (u16)(q.x & 0xffffu);
    VT[(v4 + 1) * GT + t] = (u16)(q.x >> 16);
    VT[(v4 + 2) * GT + t] = (u16)(q.y & 0xffffu);
    VT[(v4 + 3) * GT + t] = (u16)(q.y >> 16);
  }
  f32x4 ot[4];
#pragma unroll
  for (int i = 0; i < 4; ++i) ot[i] = f32x4{0.f, 0.f, 0.f, 0.f};
#pragma unroll
  for (int dir = 0; dir < 2; ++dir) {
    if (dir) __syncthreads();
#pragma unroll
    for (int k = 0; k < 4; ++k) {
      const int u = tid + 256 * k, t = u >> 4, d4 = (u & 15) * 4;
      const f32x4 cum = dir ? gcB[k] : gcF[k];
      const u32x2 q2 = gq[k];
      const u32x2 k2 = gk[k];
      const float e0 = __expf(cum[0]), e1 = __expf(cum[1]), e2 = __expf(cum[2]), e3 = __expf(cum[3]);
      const u32x2 qo = {pack2(lo2f(q2.x) * 0.125f * e0, hi2f(q2.x) * 0.125f * e1), pack2(lo2f(q2.y) * 0.125f * e2, hi2f(q2.y) * 0.125f * e3)};
      const u32x2 ko = {pack2(lo2f(k2.x) / e0, hi2f(k2.x) / e1), pack2(lo2f(k2.y) / e2, hi2f(k2.y) / e3)};
      *(u32x2*)(QH + t * GT + d4) = qo;
      *(u32x2*)(KH + t * GT + d4) = ko;
      const int d = t;
      const u32x2 s4 = dir ? gsB[k] : gsF[k];
      ST[(d4 + 0) * GT + d] = (u16)(s4.x & 0xffffu);
      ST[(d4 + 1) * GT + d] = (u16)(s4.x >> 16);
      ST[(d4 + 2) * GT + d] = (u16)(s4.y & 0xffffu);
      ST[(d4 + 3) * GT + d] = (u16)(s4.y >> 16);
    }
    __syncthreads();
    bf16x8 qf[2];
    qf[0] = *(const bf16x8*)(QH + (16 * w + l15) * GT + quad * 8);
    qf[1] = *(const bf16x8*)(QH + (16 * w + l15) * GT + 32 + quad * 8);
    f32x4 st[4];
#pragma unroll
    for (int sti = 0; sti < 4; ++sti) {
      const bf16x8 k0 = *(const bf16x8*)(KH + (sti * 16 + l15) * GT + quad * 8);
      const bf16x8 k1 = *(const bf16x8*)(KH + (sti * 16 + l15) * GT + 32 + quad * 8);
      f32x4 z = f32x4{0.f, 0.f, 0.f, 0.f};
      z = __builtin_amdgcn_mfma_f32_16x16x32_bf16(k0, qf[0], z, 0, 0, 0);
      st[sti] = __builtin_amdgcn_mfma_f32_16x16x32_bf16(k1, qf[1], z, 0, 0, 0);
      const int t = 16 * w + l15;
#pragma unroll
      for (int jj = 0; jj < 4; ++jj) {
        const int sidx = sti * 16 + quad * 4 + jj;
        const bool keep = dir ? (sidx >= t) : (sidx <= t);
        st[sti][jj] = keep ? st[sti][jj] : 0.f;
      }
    }
#pragma unroll
    for (int kk = 0; kk < 2; ++kk) {
      const u32x4 pu = {pack2(st[2 * kk][0], st[2 * kk][1]), pack2(st[2 * kk][2], st[2 * kk][3]),
                        pack2(st[2 * kk + 1][0], st[2 * kk + 1][1]), pack2(st[2 * kk + 1][2], st[2 * kk + 1][3])};
      const bf16x8 pf = __builtin_bit_cast(bf16x8, pu);
#pragma unroll
      for (int vt = 0; vt < 4; ++vt) {
        const u32x2 v0 = *(const u32x2*)(VT + (vt * 16 + l15) * GT + kk * 32 + quad * 4);
        const u32x2 v1 = *(const u32x2*)(VT + (vt * 16 + l15) * GT + kk * 32 + 16 + quad * 4);
        const u32x4 vu = {v0.x, v0.y, v1.x, v1.y};
        ot[vt] = __builtin_amdgcn_mfma_f32_16x16x32_bf16(__builtin_bit_cast(bf16x8, vu), pf, ot[vt], 0, 0, 0);
      }
    }
#pragma unroll
    for (int ks = 0; ks < 2; ++ks)
#pragma unroll
      for (int vt = 0; vt < 4; ++vt) {
        const bf16x8 sf = *(const bf16x8*)(ST + (vt * 16 + l15) * GT + ks * 32 + quad * 8);
        ot[vt] = __builtin_amdgcn_mfma_f32_16x16x32_bf16(sf, qf[ks], ot[vt], 0, 0, 0);
      }
  }
  {
    float ss = 0.f;
#pragma unroll
    for (int vt = 0; vt < 4; ++vt)
#pragma unroll
      for (int jj = 0; jj < 4; ++jj) ss += ot[vt][jj] * ot[vt][jj];
    ss += __shfl_xor(ss, 16);
    ss += __shfl_xor(ss, 32);
    const float rstd = rsqrtf(ss * (1.f / 64.f) + 1e-6f);
    const int row = r0 + 16 * w + l15;
    const float* gn = p->in[22] + l * 64;
    u16* OC = (u16*)(p->ws + OFF_OC);
#pragma unroll
    for (int vt = 0; vt < 4; ++vt) {
      const int v = vt * 16 + quad * 4;
      const f32x4 g4 = gg4[vt];
      const u32x2 rq = grq[vt];
      const float y0 = ot[vt][0] * rstd * g4[0] * silu_f(lo2f(rq.x));
      const float y1 = ot[vt][1] * rstd * g4[1] * silu_f(hi2f(rq.x));
      const float y2 = ot[vt][2] * rstd * g4[2] * silu_f(lo2f(rq.y));
      const float y3 = ot[vt][3] * rstd * g4[3] * silu_f(hi2f(rq.y));
      const u32x2 o = {pack2(y0, y1), pack2(y2, y3)};
      *(u32x2*)(OC + (size_t)row * 256 + h * 64 + v) = o;
    }
  }
}

struct Seg { const u16* K; const u16* Vt; int ks, vs, nk; };

template <int QT>
DEV void attn_item(const u16* __restrict__ Q, int qs, Seg s0, Seg s1, u16* __restrict__ O, int os, u16* sm,
                          bool na_mode, const float* rpb_h, int na_rowoff) {
  const int tid = otid(), lane = tid & 63, w = tid >> 6, quad = lane >> 4, l15 = lane & 15;
  const int qbase = w * 16 * QT;
  bf16x8 qf[QT][2];
#pragma unroll
  for (int qt = 0; qt < QT; ++qt)
#pragma unroll
    for (int ks = 0; ks < 2; ++ks)
      qf[qt][ks] = *(const bf16x8*)(Q + (size_t)(qbase + qt * 16 + l15) * qs + ks * 32 + quad * 8);
  f32x4 ot[4][QT];
  float mrow[QT], lrow[QT];
#pragma unroll
  for (int qt = 0; qt < QT; ++qt) {
    mrow[qt] = -1e30f; lrow[qt] = 0.f;
#pragma unroll
    for (int dt = 0; dt < 4; ++dt) ot[dt][qt] = f32x4{0.f, 0.f, 0.f, 0.f};
  }
  const int nt0 = s0.nk >> 6, nt = nt0 + (s1.nk >> 6);
  const int lr = tid >> 3, lc = (tid & 7) * 8;
  u32x4 rk[2][2], rv[2][2];
#define ATT_LOAD(S, T)                                                                  \
  {                                                                                     \
    const int _t = (T);                                                                 \
    const bool _f = _t < nt0;                                                           \
    const u16* _K = _f ? s0.K : s1.K; const u16* _V = _f ? s0.Vt : s1.Vt;               \
    const int _ks = _f ? s0.ks : s1.ks, _vs = _f ? s0.vs : s1.vs;                       \
    const int _k0 = (_f ? _t : _t - nt0) * 64;                                          \
    const u16* _kp = _K + (size_t)(_k0 + lr) * _ks + lc;                                \
    rk[S][0] = *(const u32x4*)_kp; rk[S][1] = *(const u32x4*)(_kp + (size_t)32 * _ks);  \
    const u16* _vp = _V + (size_t)lr * _vs + _k0 + lc;                                  \
    rv[S][0] = *(const u32x4*)_vp; rv[S][1] = *(const u32x4*)(_vp + (size_t)32 * _vs);  \
  }
#define ATT_STORE(S, BUF)                                                               \
  {                                                                                     \
    u16* _b = sm + (BUF) * (128 * LDT);                                                 \
    *(u32x4*)(_b + lr * LDT + lc) = rk[S][0]; *(u32x4*)(_b + (lr + 32) * LDT + lc) = rk[S][1]; \
    *(u32x4*)(_b + 64 * LDT + lr * LDT + lc) = rv[S][0];                                \
    *(u32x4*)(_b + 64 * LDT + (lr + 32) * LDT + lc) = rv[S][1];                         \
  }
  ATT_LOAD(0, 0);
  ATT_LOAD(1, 1);
  lds_barrier();
  ATT_STORE(0, 0);
  float* rpl = (float*)(sm + 2 * 128 * LDT);
  if (na_mode) { for (int i = tid; i < 15 * 31; i += 256) rpl[i] = rpb_h[i]; }
  lds_barrier();
  const float sc = 0.125f * 1.44269504088896f;
  for (int t2 = 0; t2 < nt; t2 += 2) {
#pragma unroll
  for (int hh = 0; hh < 2; ++hh) {
    const int t = t2 + hh;
    const u16* cK = sm + hh * (128 * LDT);
    const u16* cV = cK + 64 * LDT;
    ATT_LOAD(hh, min(t + 2, nt - 1));
    f32x4 st[4][QT];
#pragma unroll
    for (int kt = 0; kt < 4; ++kt) {
      bf16x8 k0 = *(const bf16x8*)(cK + (kt * 16 + l15) * LDT + quad * 8);
      bf16x8 k1 = *(const bf16x8*)(cK + (kt * 16 + l15) * LDT + 32 + quad * 8);
#pragma unroll
      for (int qt = 0; qt < QT; ++qt) {
        f32x4 z = f32x4{0.f, 0.f, 0.f, 0.f};
        z = __builtin_amdgcn_mfma_f32_16x16x32_bf16(k0, qf[qt][0], z, 0, 0, 0);
        st[kt][qt] = __builtin_amdgcn_mfma_f32_16x16x32_bf16(k1, qf[qt][1], z, 0, 0, 0);
      }
    }
    float sce = sc;
    if (na_mode && t < nt0) {
      const float* rp = rpl + (na_rowoff + t) * 31;
      const int qcol = qbase + l15;
      const int win0 = min(max(qcol - 8, 0), 48);
#pragma unroll
      for (int kt = 0; kt < 4; ++kt)
#pragma unroll
        for (int j = 0; j < 4; ++j) {
          const int kc = kt * 16 + quad * 4 + j;
          const bool ok = (kc >= win0) && (kc < win0 + 16);
          const int bi = min(max(kc - qcol + 15, 0), 30);
          const float bias = rp[bi];
          st[kt][0][j] = ok ? (st[kt][0][j] * sc + bias * 1.44269504088896f) : -1e30f;
        }
      sce = 1.f;
    }
#pragma unroll
    for (int qt = 0; qt < QT; ++qt) {
      float mx = fmaxf(fmaxf(st[0][qt][0], st[0][qt][1]), fmaxf(st[0][qt][2], st[0][qt][3]));
#pragma unroll
      for (int kt = 1; kt < 4; ++kt)
        mx = fmaxf(mx, fmaxf(fmaxf(st[kt][qt][0], st[kt][qt][1]), fmaxf(st[kt][qt][2], st[kt][qt][3])));
      mx = fmaxf(mx, __shfl_xor(mx, 16));
      mx = fmaxf(mx, __shfl_xor(mx, 32));
      const float mold = mrow[qt];
      const float mnew = fmaxf(mold, mx * sce);
      const float alpha = __builtin_amdgcn_exp2f(mold - mnew);
      mrow[qt] = mnew;
      float ls = 0.f;
#pragma unroll
      for (int kt = 0; kt < 4; ++kt)
#pragma unroll
        for (int j = 0; j < 4; ++j) {
          const float pv = __builtin_amdgcn_exp2f(__builtin_fmaf(st[kt][qt][j], sce, -mnew));
          st[kt][qt][j] = pv; ls += pv;
        }
      lrow[qt] = lrow[qt] * alpha + ls;
      if (__any(mnew != mold)) {
#pragma unroll
        for (int dt = 0; dt < 4; ++dt) ot[dt][qt] *= alpha;
      }
    }
#pragma unroll
    for (int kk = 0; kk < 2; ++kk) {
      bf16x8 pf[QT];
#pragma unroll
      for (int qt = 0; qt < QT; ++qt) {
        uint4 u = make_uint4(pack2(st[2 * kk][qt][0], st[2 * kk][qt][1]), pack2(st[2 * kk][qt][2], st[2 * kk][qt][3]),
                             pack2(st[2 * kk + 1][qt][0], st[2 * kk + 1][qt][1]), pack2(st[2 * kk + 1][qt][2], st[2 * kk + 1][qt][3]));
        pf[qt] = __builtin_bit_cast(bf16x8, u);
      }
#pragma unroll
      for (int dt = 0; dt < 4; ++dt) {
        uint2 v0 = *(const uint2*)(cV + (dt * 16 + l15) * LDT + kk * 32 + quad * 4);
        uint2 v1 = *(const uint2*)(cV + (dt * 16 + l15) * LDT + kk * 32 + 16 + quad * 4);
        bf16x8 vf = __builtin_bit_cast(bf16x8, make_uint4(v0.x, v0.y, v1.x, v1.y));
#pragma unroll
        for (int qt = 0; qt < QT; ++qt)
          ot[dt][qt] = __builtin_amdgcn_mfma_f32_16x16x32_bf16(vf, pf[qt], ot[dt][qt], 0, 0, 0);
      }
    }
    ATT_STORE(hh ^ 1, hh ^ 1);
    lds_barrier();
  }
  }
#pragma unroll
  for (int qt = 0; qt < QT; ++qt) {
    float ls = lrow[qt];
    ls += __shfl_xor(ls, 16);
    ls += __shfl_xor(ls, 32);
    const float inv = 1.f / ls;
    const int q = qbase + qt * 16 + l15;
#pragma unroll
    for (int dt = 0; dt < 4; ++dt)
      *(uint2*)(O + (size_t)q * os + dt * 16 + quad * 4) =
          make_uint2(pack2(ot[dt][qt][0] * inv, ot[dt][qt][1] * inv), pack2(ot[dt][qt][2] * inv, ot[dt][qt][3] * inv));
  }
#undef ATT_LOAD
#undef ATT_STORE
}

DEV void phase_attention(PP p, int l, u16* sm) {
  const u16* PROJ = (const u16*)(p->ws + OFF_PROJ);
  u16* OA = (u16*)(p->ws + OFF_OA);
  u16* OB = (u16*)(p->ws + OFF_OB);
  const int NG2 = 34 * 32;
  const int total = NG2 + 512 + 512 + 256 + 512;
  for (int item = VB; item < total; item += VG) {
    int idx = item;
    if (idx < NG2) { gla_g2_item(p, l, idx); continue; }
    idx -= NG2;
    if (idx < 512) {
      int b = idx >> 8, hq = (idx >> 5) & 7, qb = idx & 31;
      if (VG == 512) {
        const int v = (NG2 + idx) & 511, blk = v >> 1, xcd = blk & 7, slot = blk >> 3;
        const int pair = xcd >> 1, wv = ((((xcd & 1) << 5) + slot) << 1) | (v & 1);
        b = pair >> 1; hq = (pair & 1) * 4 + (wv >> 5); qb = wv & 31;
      }
      const int kvh = hq >> 2;
      const size_t rowb = 8192 + (size_t)b * 4096;
      Seg s0{PROJ + rowb * NP + C_KB + kvh * 64, (const u16*)(p->ws + OFF_VTB_S) + (size_t)(b * 2 + kvh) * 64 * LDVS, NP, LDVS, 4096};
      Seg s1{(const u16*)(p->ws + OFF_CKB) + (size_t)((l * 2 + b) * 2 + kvh) * 512 * 64,
             (const u16*)(p->ws + OFF_CVTB) + (size_t)((l * 2 + b) * 2 + kvh) * 64 * 512, 64, 512, 512};
      attn_item<2>(PROJ + (rowb + qb * 128) * NP + C_QB + hq * 64, NP, s0, s1, OB + (rowb + qb * 128) * 512 + hq * 64, 512, sm,
                   false, nullptr, 0);
      continue;
    }
    idx -= 512;
    if (idx < 512) {
      int b = idx >> 8, h = (idx >> 6) & 3, r = idx & 63;
      if (VG == 512) {
        const int v = (NG2 + 512 + idx) & 511, blk = v >> 1, xcd = blk & 7, slot = blk >> 3;
        b = xcd >> 2; h = xcd & 3; r = (slot << 1) | (v & 1);
      }
      const int kr0 = min(max(r - 4, 0), 56);
      const size_t rowb = 8192 + (size_t)b * 4096;
      Seg s0{PROJ + (rowb + kr0 * 64) * NP + C_KA + h * 64,
             (const u16*)(p->ws + OFF_VTA_S) + (size_t)(b * 4 + h) * 64 * LDVS + kr0 * 64, NP, LDVS, 512};
      Seg s1{(const u16*)(p->ws + OFF_CKA) + (size_t)((l * 2 + b) * 4 + h) * 512 * 64,
             (const u16*)(p->ws + OFF_CVTA) + (size_t)((l * 2 + b) * 4 + h) * 64 * 512, 64, 512, 512};
      attn_item<1>(PROJ + (rowb + r * 64) * NP + C_QA + h * 64, NP, s0, s1, OA + (rowb + r * 64) * 256 + h * 64, 256, sm,
                   true, p->in[17] + (size_t)(l * 4 + h) * 15 * 31, kr0 - r + 7);
      continue;
    }
    idx -= 512;
    if (idx < 256) {
      const int b = idx >> 3, h = (idx >> 1) & 3, qb = idx & 1;
      const size_t rowb = (size_t)b * 256;
      Seg s0{PROJ + rowb * NP + C_KA + h * 64, (const u16*)(p->ws + OFF_VTA_P) + (size_t)(b * 4 + h) * 64 * 256, NP, 256, 256};
      Seg s1{nullptr, nullptr, 0, 0, 0};
      attn_item<2>(PROJ + (rowb + qb * 128) * NP + C_QA + h * 64, NP, s0, s1, OA + (rowb + qb * 128) * 256 + h * 64, 256, sm,
                   false, nullptr, 0);
      continue;
    }
    idx -= 256;
    {
      const int b = idx >> 4, hq = (idx >> 1) & 7, qb = idx & 1, kvh = hq >> 2;
      const size_t rowb = (size_t)b * 256;
      Seg s0{PROJ + rowb * NP + C_KB + kvh * 64, (const u16*)(p->ws + OFF_VTB_P) + (size_t)(b * 2 + kvh) * 64 * 256, NP, 256, 256};
      Seg s1{nullptr, nullptr, 0, 0, 0};
      attn_item<2>(PROJ + (rowb + qb * 128) * NP + C_QB + hq * 64, NP, s0, s1, OB + (rowb + qb * 128) * 512 + hq * 64, 512, sm,
                   false, nullptr, 0);
    }
  }
}

DEV void phase_conv(PP p, int l) {
  const u16* U = (const u16*)(p->ws + OFF_PROJ);
  u16* ACT = (u16*)(p->ws + OFF_ACT);
  const float* cw = p->in[28] + (size_t)l * 3 * 5632;
  const float* cb = p->in[29] + (size_t)l * 5632;
  const int total = 2048 * 352;
  const int tid = otid();
  for (int u = VB * 256 + tid; u < total; u += VG * 256) {
    const int rc = u / 352, cgp = u % 352;
    const int c0 = cgp * 8, r0 = rc * 8;
    const int seqlen = r0 < 8192 ? 256 : 4096;
    const int pos = r0 & (seqlen - 1);
    const bool hasprev = pos != 0, hasnext = (pos + 8) < seqlen;
    u32x4 ra[10], rg[10];
    const u32x4 zero4 = {0u, 0u, 0u, 0u};
#pragma unroll
    for (int i = 0; i < 10; ++i) {
      const bool ok = (i == 0) ? hasprev : (i == 9 ? hasnext : true);
      const int row = ok ? (r0 - 1 + i) : r0;
      u32x4 a = *(const u32x4*)(U + (size_t)row * 5632 + c0);
      u32x4 g = *(const u32x4*)(U + (size_t)row * 5632 + 2816 + c0);
      ra[i] = ok ? a : zero4;
      rg[i] = ok ? g : zero4;
    }
    float wa[3][8], wg[3][8], ba[8], bg[8];
#pragma unroll
    for (int j = 0; j < 3; ++j) {
      f32x4 t0 = *(const f32x4*)(cw + j * 5632 + c0), t1 = *(const f32x4*)(cw + j * 5632 + c0 + 4);
      f32x4 t2 = *(const f32x4*)(cw + j * 5632 + 2816 + c0), t3 = *(const f32x4*)(cw + j * 5632 + 2816 + c0 + 4);
#pragma unroll
      for (int q = 0; q < 4; ++q) { wa[j][q] = t0[q]; wa[j][4 + q] = t1[q]; wg[j][q] = t2[q]; wg[j][4 + q] = t3[q]; }
    }
    {
      f32x4 t0 = *(const f32x4*)(cb + c0), t1 = *(const f32x4*)(cb + c0 + 4);
      f32x4 t2 = *(const f32x4*)(cb + 2816 + c0), t3 = *(const f32x4*)(cb + 2816 + c0 + 4);
#pragma unroll
      for (int q = 0; q < 4; ++q) { ba[q] = t0[q]; ba[4 + q] = t1[q]; bg[q] = t2[q]; bg[4 + q] = t3[q]; }
    }
#pragma unroll
    for (int i = 0; i < 8; ++i) {
      u32x4 o;
#pragma unroll
      for (int q = 0; q < 4; ++q) {
        float a0 = ba[2 * q] + lo2f(ra[i][q]) * wa[0][2 * q] + lo2f(ra[i + 1][q]) * wa[1][2 * q] + lo2f(ra[i + 2][q]) * wa[2][2 * q];
        float a1 = ba[2 * q + 1] + hi2f(ra[i][q]) * wa[0][2 * q + 1] + hi2f(ra[i + 1][q]) * wa[1][2 * q + 1] + hi2f(ra[i + 2][q]) * wa[2][2 * q + 1];
        float g0 = bg[2 * q] + lo2f(rg[i][q]) * wg[0][2 * q] + lo2f(rg[i + 1][q]) * wg[1][2 * q] + lo2f(rg[i + 2][q]) * wg[2][2 * q];
        float g1 = bg[2 * q + 1] + hi2f(rg[i][q]) * wg[0][2 * q + 1] + hi2f(rg[i + 1][q]) * wg[1][2 * q + 1] + hi2f(rg[i + 2][q]) * wg[2][2 * q + 1];
        o[q] = pack2(a0 * silu_f(g0), a1 * silu_f(g1));
      }
      *(u32x4*)(ACT + (size_t)(r0 + i) * LDACT + c0) = o;
    }
  }
}

__global__ void __launch_bounds__(512, 2) trunk_megakernel(Params p_unused) {
  extern __shared__ __attribute__((aligned(16))) unsigned char smem_raw[];
  u16* smg = (u16*)smem_raw;
  u16* sm = (u16*)(smem_raw + vhalf() * HALF_LDS);
  float* smf = (float*)sm;
  cg::grid_group grid = cg::this_grid();
  volatile LAS unsigned* bst = (volatile LAS unsigned*)(smem_raw + (LDS_BYTES - 16));
  if (threadIdx.x == 0) { bst[0] = 0u; bst[1] = 0u; }
  __syncthreads();
  XcdBarrier xb;
  { PP p = load_params(); xb = xcd_barrier_post((unsigned*)(p->ws + OFF_BAR), bst); }

  { PP p = load_params(); phase_mod(p, smf); }
  { PP p = load_params(); phase_cache(p); }
  { PP p = load_params(); if (p->ws == nullptr) grid.sync(); }
  xcd_barrier(xb);

#pragma unroll 1
  for (int l = 0; l < 4; ++l) {
    { PP p = load_params(); phase_convert_weights(p, l, smf); }
    { PP p = load_params(); phase_norm(p, l, 0); }
    xcd_barrier(xb);
    { PP p = load_params();
      phase_gemm_store((const u16*)(p->ws + OFF_H), LDH, (const u16*)(p->ws + OFF_WT_IN), LDW1, 1024, 23, (u16*)(p->ws + OFF_PROJ), NP, smg, p, l, true); }
    xcd_barrier(xb);
    { PP p = load_params();
      for (int item = VB; item < 1024; item += VG) gla_g1_item(p, l, item >> 2, item & 3, smf); }
    xcd_barrier(xb);
    { PP p = load_params(); phase_attention(p, l, sm); }
    xcd_barrier(xb);
    { PP p = load_params();
      for (int item = VB; item < 1024; item += VG) gla_g3_item(p, l, item >> 2, item & 3, sm); }
    xcd_barrier(xb);
    { PP p = load_params(); phase_gemm_merge(p, smg); }
    xcd_barrier(xb);
    { PP p = load_params();
      phase_gemm_resid((const u16*)(p->ws + OFF_H), LDH, (const u16*)(p->ws + OFF_WT_OUT), LDW1, 1024, (u16*)(p->ws + OFF_XB),
                       (const float*)(p->ws + OFF_MOD) + (size_t)l * 3 * 6144 + 2048, smg, nullptr); }
    xcd_barrier(xb);
    { PP p = load_params(); phase_norm(p, l, 1); }
    xcd_barrier(xb);
    { PP p = load_params(); phase_gemm_up_conv(p, l, smg); }
    xcd_barrier(xb);
    { PP p = load_params();
      phase_gemm_resid((const u16*)(p->ws + OFF_ACT), LDACT, (const u16*)(p->ws + OFF_WT_DN), LDACT, DFF, (u16*)(p->ws + OFF_XB),
                       (const float*)(p->ws + OFF_MOD) + (size_t)l * 3 * 6144 + 5120, smg, l == 3 ? p->out : nullptr, p, l); }
    xcd_barrier(xb);
  }
}

extern "C" void kernel_launch(void* const* d_in, const int* in_sizes, int n_in, void* d_out, int out_size, void* d_ws,
                              size_t ws_size, hipStream_t stream) {
  static int grid_blocks = 0;
  if (grid_blocks == 0) {
    if (n_in != 31 || ws_size < WS_END) {
      fprintf(stderr, "kernel_launch: unexpected inputs (n_in %d) or workspace too small (%zu < %zu)\n", n_in, ws_size, (size_t)WS_END);
      grid_blocks = -1;
      return;
    }
    int dev = 0, cus = 0, per_cu = 0;
    hipGetDevice(&dev);
    hipDeviceGetAttribute(&cus, hipDeviceAttributeMultiprocessorCount, dev);
    hipFuncSetAttribute((const void*)trunk_megakernel, hipFuncAttributeMaxDynamicSharedMemorySize, LDS_BYTES);
    hipOccupancyMaxActiveBlocksPerMultiprocessor(&per_cu, (const void*)trunk_megakernel, 512, LDS_BYTES);
    per_cu = 1;
    grid_blocks = cus * per_cu;
  }
  if (grid_blocks < 0) return;
  Params p{};
  for (int i = 0; i < 31; ++i) p.in[i] = (const float*)d_in[i];
  p.out = (float*)d_out;
  p.ws = (unsigned char*)d_ws;
  if (hipMemsetAsync((unsigned char*)d_ws + OFF_BAR, 0, 16384, stream) != hipSuccess) fprintf(stderr, "kernel_launch: memset of barrier words failed\n");
  void* args[] = {&p};
  hipError_t e = hipLaunchCooperativeKernel((const void*)trunk_megakernel, dim3(grid_blocks), dim3(512), args, LDS_BYTES, stream);
  if (e != hipSuccess) fprintf(stderr, "cooperative launch failed: %s (grid %d)\n", hipGetErrorString(e), grid_blocks);
}
```

```cpp
#include <hip/hip_runtime.h>
#include <hip/hip_cooperative_groups.h>
#include <cstdio>
namespace cg = cooperative_groups;

typedef unsigned short u16;
typedef __attribute__((ext_vector_type(8))) short bf16x8;
typedef __attribute__((ext_vector_type(4))) float f32x4;
typedef __attribute__((ext_vector_type(4))) unsigned u32x4;
typedef __attribute__((ext_vector_type(2))) unsigned u32x2;

#define DEV __device__ __forceinline__

#define NTOK 16384
#define DM 1024
#define NP 5888
#define DIN 5664
#define DFF 2816
#define LDH 1088
#define LDW1 1088
#define LDACT 2880
#define LDVS 4160
#define C_QA 0
#define C_KA 256
#define C_VA 512
#define C_QB 768
#define C_KB 1280
#define C_VB 1408
#define C_QC 1536
#define C_KC 1792
#define C_VC 2048
#define C_RC 2304
#define C_ZF 2560
#define C_GA 2592
#define C_GB 3616
#define C_GC 4640

constexpr size_t OFF_WT_IN  = 0;
constexpr size_t OFF_WT_A   = OFF_WT_IN  + (size_t)NP * LDW1 * 2;
constexpr size_t OFF_WT_B   = OFF_WT_A   + (size_t)1024 * 256 * 2;
constexpr size_t OFF_WT_C   = OFF_WT_B   + (size_t)1024 * 512 * 2;
constexpr size_t OFF_WT_OUT = OFF_WT_C   + (size_t)1024 * 256 * 2;
constexpr size_t OFF_WT_UP  = OFF_WT_OUT + (size_t)1024 * LDW1 * 2;
constexpr size_t OFF_WT_DN  = OFF_WT_UP  + (size_t)5632 * LDW1 * 2;
constexpr size_t OFF_MOD    = OFF_WT_DN  + (size_t)1024 * LDACT * 2;
constexpr size_t OFF_CKA    = OFF_MOD    + (size_t)4 * 3 * 6144 * 4;
constexpr size_t OFF_CVTA   = OFF_CKA    + (size_t)1048576 * 2;
constexpr size_t OFF_CKB    = OFF_CVTA   + (size_t)1048576 * 2;
constexpr size_t OFF_CVTB   = OFF_CKB    + (size_t)524288 * 2;
constexpr size_t OFF_H      = OFF_CVTB   + (size_t)524288 * 2;
constexpr size_t OFF_PROJ   = OFF_H      + (size_t)NTOK * LDH * 2;
constexpr size_t OFF_ACT    = OFF_PROJ   + (size_t)NTOK * NP * 2;
constexpr size_t OFF_KVF    = OFF_ACT;
constexpr size_t OFF_KVB    = OFF_KVF    + (size_t)1024 * 4096 * 4;
constexpr size_t OFF_CUMF   = OFF_KVB    + (size_t)1024 * 4096 * 4;
constexpr size_t OFF_CUMB   = OFF_CUMF   + (size_t)NTOK * 256 * 4;
constexpr size_t OFF_DF     = OFF_CUMB   + (size_t)NTOK * 256 * 4;
constexpr size_t OFF_DB     = OFF_DF     + (size_t)1024 * 64 * 4;
constexpr size_t OFF_OA     = OFF_ACT    + (size_t)NTOK * LDACT * 2;
constexpr size_t OFF_OB     = OFF_OA     + (size_t)NTOK * 256 * 2;
constexpr size_t OFF_OC     = OFF_OB     + (size_t)NTOK * 512 * 2;
constexpr size_t OFF_VTA_P  = OFF_OC     + (size_t)NTOK * 256 * 2;
constexpr size_t OFF_VTA_S  = OFF_VTA_P  + (size_t)32 * 4 * 64 * 256 * 2;
constexpr size_t OFF_VTB_P  = OFF_VTA_S  + (size_t)2 * 4 * 64 * LDVS * 2;
constexpr size_t OFF_VTB_S  = OFF_VTB_P  + (size_t)32 * 2 * 64 * 256 * 2;
constexpr size_t OFF_BAR    = OFF_VTB_S  + (size_t)2 * 2 * 64 * LDVS * 2;
constexpr size_t OFF_XB     = OFF_BAR    + 16384;
constexpr size_t WS_END     = OFF_XB     + (size_t)NTOK * 1024 * 2;

constexpr size_t OUT_NAK = 16777216, OUT_NAV = 25165824, OUT_GQK = 33554432, OUT_GQV = 37748736,
                 OUT_GLF = 41943040, OUT_GLB = 44040192;

#define LDS_BYTES (2 * 73728 + 16)

struct Params {
  const float* in[31];
  float* out;
  unsigned char* ws;
};

#if defined(__HIP_DEVICE_COMPILE__)
#define AS4 __attribute__((address_space(4)))
#else
#define AS4
#endif
typedef const AS4 Params* PP;
DEV PP load_params() {
#if defined(__HIP_DEVICE_COMPILE__)
  PP k = (PP)__builtin_amdgcn_kernarg_segment_ptr();
  asm volatile("" : "+s"(k));
  return k;
#else
  return nullptr;
#endif
}

DEV u16 f2bf(float f) { return __builtin_bit_cast(u16, (__bf16)f); }
DEV float bf2f(u16 h) { return __uint_as_float(((unsigned)h) << 16); }
typedef __bf16 bf16x2_t __attribute__((ext_vector_type(2)));
typedef float float2_t __attribute__((ext_vector_type(2)));
DEV unsigned pack2(float a, float b) {
  float2_t f = {a, b};
  bf16x2_t h = __builtin_convertvector(f, bf16x2_t);
  return __builtin_bit_cast(unsigned, h);
}
DEV float lo2f(unsigned u) { return __uint_as_float(u << 16); }
DEV float hi2f(unsigned u) { return __uint_as_float(u & 0xffff0000u); }
DEV float silu_f(float x) { return x / (1.f + __expf(-x)); }
DEV float sigm_f(float x) { return 1.f / (1.f + __expf(-x)); }
DEV float logsig_f(float x) { return fminf(x, 0.f) - __logf(1.f + __expf(-fabsf(x))); }
DEV float wave_sum(float v) {
#pragma unroll
  for (int o = 32; o; o >>= 1) v += __shfl_xor(v, o);
  return v;
}
DEV int otid() { int t = threadIdx.x & 255; asm volatile("" : "+v"(t)); return t; }
DEV int ftid() { int t = threadIdx.x; asm volatile("" : "+v"(t)); return t; }
DEV int vhalf() { return __builtin_amdgcn_readfirstlane((int)(threadIdx.x >> 8)); }
#define VB (blockIdx.x * 2 + vhalf())
#define VG (gridDim.x * 2)
#define HALF_LDS 73728
DEV void lds_barrier() { asm volatile("s_waitcnt lgkmcnt(0)\n\ts_barrier" ::: "memory"); }

#define XB_TMO      128
#define XB_XCNT(j)  (256  + 64 * (j))
#define XB_XSUB(j)  (1280 + 64 * (j))
#define XB_XGEN(j)  (2304 + 64 * (j))
#define XB_TOP      3328
#define XB_TOPGEN   3392
#define XCD_BAR_WORDS 3456
#define XB_SPIN_CAP (1u << 22)
#define LAS __attribute__((address_space(3)))
DEV unsigned xb_ld(unsigned* p) { return __hip_atomic_load(p, __ATOMIC_RELAXED, __HIP_MEMORY_SCOPE_AGENT); }
DEV unsigned xb_add(unsigned* p, unsigned v) { return __hip_atomic_fetch_add(p, v, __ATOMIC_RELAXED, __HIP_MEMORY_SCOPE_AGENT); }
DEV unsigned xb_xcc_id() { return (unsigned)__builtin_amdgcn_s_getreg((3 << 11) | 20) & 0xFu; }
#define XB_SPIN(cond, bar) do { unsigned _sp = 0; while (cond) { __builtin_amdgcn_s_sleep(1); \
    if ((++_sp & 255u) == 0u) { if (xb_ld(&(bar)[XB_TMO])) break; if (_sp > XB_SPIN_CAP) { atomicAdd(&(bar)[XB_TMO], 1u); break; } } } } while (0)
struct XcdBarrier { unsigned* bar; unsigned x; volatile LAS unsigned* st; };
DEV XcdBarrier xcd_barrier_post(unsigned* bar, volatile LAS unsigned* st) {
  XcdBarrier b; b.bar = bar; b.x = xb_xcc_id(); b.st = st;
  if (threadIdx.x == 0) (void)xb_add(&bar[XB_XCNT(b.x)], 1u);
  return b;
}
DEV void xcd_barrier_complete(unsigned* bar, unsigned x, unsigned& nloc, unsigned& nx) {
  const unsigned G = gridDim.x * gridDim.y * gridDim.z;
  unsigned sum, cnt, mine, sp = 0u;
  for (;;) {
    sum = 0u; cnt = 0u; mine = 0u;
#pragma unroll
    for (unsigned j = 0; j < 16; ++j) { const unsigned c = xb_ld(&bar[XB_XCNT(j)]); sum += c; cnt += (c > 0u) ? 1u : 0u; mine = (j == x) ? c : mine; }
    if (sum == G) break;
    __builtin_amdgcn_s_sleep(1);
    if ((++sp & 255u) == 0u) { if (xb_ld(&bar[XB_TMO])) break; if (sp > XB_SPIN_CAP) { atomicAdd(&bar[XB_TMO], 1u); break; } }
  }
  nloc = mine > 0u ? mine : 1u; nx = cnt > 0u ? cnt : 1u;
}
DEV void xcd_barrier(const XcdBarrier& b) {
  asm volatile("s_waitcnt vmcnt(0)" ::: "memory");
  __syncthreads();
  if (threadIdx.x == 0) {
    unsigned* bar = b.bar;
    __builtin_amdgcn_s_waitcnt(0);
    unsigned nloc = b.st[0], nx = b.st[1];
    if (nloc == 0u) { xcd_barrier_complete(bar, b.x, nloc, nx); b.st[0] = nloc; b.st[1] = nx; }
    const unsigned old = xb_add(&bar[XB_XSUB(b.x)], 1u);
    const unsigned gen = old / nloc;
    if (old + 1u == (gen + 1u) * nloc) {
      __builtin_amdgcn_fence(__ATOMIC_RELEASE, "agent");
      asm volatile("s_waitcnt vmcnt(0)" ::: "memory");
      const unsigned og = xb_add(&bar[XB_TOP], 1u);
      const unsigned tg = og / nx;
      if (og + 1u == (tg + 1u) * nx) xb_add(&bar[XB_TOPGEN], 1u);
      else XB_SPIN(xb_ld(&bar[XB_TOPGEN]) == tg, bar);
      __builtin_amdgcn_fence(__ATOMIC_ACQUIRE, "agent");
      xb_add(&bar[XB_XGEN(b.x)], 1u);
      asm volatile("s_waitcnt vmcnt(0)" ::: "memory");
    } else {
      XB_SPIN(xb_ld(&bar[XB_XGEN(b.x)]) == gen, bar);
      __builtin_amdgcn_fence(__ATOMIC_ACQUIRE, "agent");
      asm volatile("s_waitcnt vmcnt(0)" ::: "memory");
    }
  }
  __syncthreads();
}

DEV int cond_of(int row) { return row < 8192 ? 0 : 1 + ((row - 8192) >> 12); }

DEV void phase_mod(PP p, float* smf) {
  const int tid = otid();
  const float* c = p->in[8];
  const float* cctx = p->in[9];
  float* MOD = (float*)(p->ws + OFF_MOD);
  __syncthreads();
  for (int i = tid; i < 3072; i += 256) {
    int ci = i >> 10, k = i & 1023;
    float v = ci == 0 ? cctx[k] : c[(ci - 1) * 1024 + k];
    smf[i] = silu_f(v);
  }
  __syncthreads();
  float* part = smf + 3072;
  for (int it = VB; it < 4 * 96; it += VG) {
    const int l = it / 96, n0 = (it % 96) * 64;
    const int col = tid & 63, kg = tid >> 6;
    const float* W = p->in[10] + ((size_t)l * 1024 + kg * 256) * 6144 + n0 + col;
    float a0 = 0.f, a1 = 0.f, a2 = 0.f;
#pragma unroll 8
    for (int k = 0; k < 256; ++k) {
      float w = W[(size_t)k * 6144];
      int kk = kg * 256 + k;
      a0 += smf[kk] * w; a1 += smf[1024 + kk] * w; a2 += smf[2048 + kk] * w;
    }
    part[(kg * 3 + 0) * 64 + col] = a0;
    part[(kg * 3 + 1) * 64 + col] = a1;
    part[(kg * 3 + 2) * 64 + col] = a2;
    __syncthreads();
    if (tid < 192) {
      int ci = tid >> 6, cc = tid & 63;
      float s = part[(0 * 3 + ci) * 64 + cc] + part[(1 * 3 + ci) * 64 + cc] + part[(2 * 3 + ci) * 64 + cc] +
                part[(3 * 3 + ci) * 64 + cc] + p->in[11][l * 6144 + n0 + cc];
      MOD[(l * 3 + ci) * 6144 + n0 + cc] = s;
    }
    __syncthreads();
  }
}

DEV void phase_cache(PP p) {
  u16* CKA = (u16*)(p->ws + OFF_CKA);
  u16* CVTA = (u16*)(p->ws + OFF_CVTA);
  u16* CKB = (u16*)(p->ws + OFF_CKB);
  u16* CVTB = (u16*)(p->ws + OFF_CVTB);
  const int gtid = VB * 256 + otid(), gsz = VG * 256;
  for (int i = gtid; i < 1048576; i += gsz) {
    {
      int d = i & 63, pp = (i >> 6) & 511, h = (i >> 15) & 3, b = (i >> 17) & 1, l = i >> 18;
      CKA[i] = f2bf(p->in[2][((((size_t)b * 4 + l) * 512 + pp) * 4 + h) * 64 + d]);
    }
    {
      int pp = i & 511, d = (i >> 9) & 63, h = (i >> 15) & 3, b = (i >> 17) & 1, l = i >> 18;
      CVTA[i] = f2bf(p->in[3][((((size_t)b * 4 + l) * 512 + pp) * 4 + h) * 64 + d]);
    }
  }
  for (int i = gtid; i < 524288; i += gsz) {
    {
      int d = i & 63, pp = (i >> 6) & 511, h = (i >> 15) & 1, b = (i >> 16) & 1, l = i >> 17;
      CKB[i] = f2bf(p->in[4][((((size_t)b * 4 + l) * 512 + pp) * 2 + h) * 64 + d]);
    }
    {
      int pp = i & 511, d = (i >> 9) & 63, h = (i >> 15) & 1, b = (i >> 16) & 1, l = i >> 17;
      CVTB[i] = f2bf(p->in[5][((((size_t)b * 4 + l) * 512 + pp) * 2 + h) * 64 + d]);
    }
  }
}

DEV void transpose_convert(const float* __restrict__ W, int K, int N, u16* __restrict__ WT, int Npad, int ldw,
                                  float* tile, int& base, bool cmap = false) {
  const int G = VG, tid = otid();
  const int nkt = K >> 6, nnt = Npad >> 6, ntiles = nkt * nnt;
  const int start = (int)(((long)VB - (base % G) + G) % G);
  const int col = tid & 63, r = tid >> 6;
  float v[16];
#define TC_LOAD(T)                                                                      \
  {                                                                                     \
    const int _k0 = ((T) % nkt) * 64, _n0 = ((T) / nkt) * 64;                           \
    const int _np = _n0 + col;                                                          \
    const int _sc = cmap ? ((_np >> 8) * 128 + (_np & 127) + ((_np & 128) ? 2816 : 0)) : _np; \
    const bool _ok = _sc < N;                                                           \
    const float* _src = W + (size_t)(_k0 + r) * N + (_ok ? _sc : 0);                    \
    _Pragma("unroll") for (int i = 0; i < 16; ++i) { float _x = _src[(size_t)(4 * i) * N]; v[i] = _ok ? _x : 0.f; } \
  }
  if (start < ntiles) TC_LOAD(start);
  for (int t = start; t < ntiles; t += G) {
    const int kt = t % nkt, nt = t / nkt;
    const int k0 = kt * 64, n0 = nt * 64;
    __syncthreads();
#pragma unroll
    for (int i = 0; i < 16; ++i) tile[(r + 4 * i) * 65 + col] = v[i];
    if (t + G < ntiles) TC_LOAD(t + G);
    __syncthreads();
    {
      const int n = tid >> 2, kc = (tid & 3) * 16;
      unsigned o[8];
#pragma unroll
      for (int j = 0; j < 8; ++j) o[j] = pack2(tile[(kc + 2 * j) * 65 + n], tile[(kc + 2 * j + 1) * 65 + n]);
      u32x4* dst = (u32x4*)(WT + (size_t)(n0 + n) * ldw + k0 + kc);
      dst[0] = u32x4{o[0], o[1], o[2], o[3]};
      dst[1] = u32x4{o[4], o[5], o[6], o[7]};
    }
  }
#undef TC_LOAD
  base += ntiles;
}

DEV void phase_convert_weights(PP p, int l, float* smf) {
  int base = 0;
  transpose_convert(p->in[14] + (size_t)l * 1024 * DIN, 1024, DIN, (u16*)(p->ws + OFF_WT_IN), NP, LDW1, smf, base);
  transpose_convert(p->in[27] + (size_t)l * 1024 * 5632, 1024, 5632, (u16*)(p->ws + OFF_WT_UP), 5632, LDW1, smf, base, true);
  transpose_convert(p->in[30] + (size_t)l * 2816 * 1024, 2816, 1024, (u16*)(p->ws + OFF_WT_DN), 1024, LDACT, smf, base);
  transpose_convert(p->in[26] + (size_t)l * 1024 * 1024, 1024, 1024, (u16*)(p->ws + OFF_WT_OUT), 1024, LDW1, smf, base);
  transpose_convert(p->in[23] + (size_t)l * 256 * 1024, 256, 1024, (u16*)(p->ws + OFF_WT_A), 1024, 256, smf, base);
  transpose_convert(p->in[24] + (size_t)l * 512 * 1024, 512, 1024, (u16*)(p->ws + OFF_WT_B), 1024, 512, smf, base);
  transpose_convert(p->in[25] + (size_t)l * 256 * 1024, 256, 1024, (u16*)(p->ws + OFF_WT_C), 1024, 256, smf, base);
}

DEV void phase_norm(PP p, int l, int which) {
  const int tid0 = otid();
  const int lane = tid0 & 63, w = tid0 >> 6;
  const float* g = p->in[which ? 13 : 12] + l * 1024;
  const float* MOD = (const float*)(p->ws + OFF_MOD);
  u16* H = (u16*)(p->ws + OFF_H);
  u16* XB = (u16*)(p->ws + OFF_XB);
  const bool first = (l == 0 && which == 0);
  for (int grp = VB * 4 + w; grp < NTOK / 4; grp += VG * 4) {
    const int row0 = grp * 4;
    const float* md = MOD + (l * 3 + cond_of(row0)) * 6144 + which * 3072;
    f32x4 v[4][4];
    if (first) {
      const float* xr = row0 < 8192 ? p->in[0] + (size_t)row0 * 1024 : p->in[1] + (size_t)(row0 - 8192) * 1024;
#pragma unroll
      for (int r = 0; r < 4; ++r)
#pragma unroll
        for (int i = 0; i < 4; ++i) v[r][i] = *(const f32x4*)(xr + (size_t)r * 1024 + i * 256 + lane * 4);
    } else {
#pragma unroll
      for (int r = 0; r < 4; ++r)
#pragma unroll
        for (int i = 0; i < 4; ++i) {
          const u32x2 q = *(const u32x2*)(XB + (size_t)(row0 + r) * 1024 + i * 256 + lane * 4);
          v[r][i] = f32x4{lo2f(q.x), hi2f(q.x), lo2f(q.y), hi2f(q.y)};
        }
    }
    float rstd[4];
#pragma unroll
    for (int r = 0; r < 4; ++r) {
      float ss = 0.f;
#pragma unroll
      for (int i = 0; i < 4; ++i) ss += v[r][i][0] * v[r][i][0] + v[r][i][1] * v[r][i][1] + v[r][i][2] * v[r][i][2] + v[r][i][3] * v[r][i][3];
      ss = wave_sum(ss);
      rstd[r] = rsqrtf(ss * (1.f / 1024.f) + 1e-6f);
    }
#pragma unroll
    for (int i = 0; i < 4; ++i) {
      const int col = i * 256 + lane * 4;
      const f32x4 gg = *(const f32x4*)(g + col);
      const f32x4 sh = *(const f32x4*)(md + col);
      const f32x4 sc = *(const f32x4*)(md + 1024 + col);
      const f32x4 gs = gg * (sc + 1.f);
#pragma unroll
      for (int r = 0; r < 4; ++r) {
        const f32x4 hv = v[r][i] * rstd[r] * gs + sh;
        const u32x2 o = {pack2(hv[0], hv[1]), pack2(hv[2], hv[3])};
        *(u32x2*)(H + (size_t)(row0 + r) * LDH + col) = o;
        if (first) { const u32x2 xo = {pack2(v[r][i][0], v[r][i][1]), pack2(v[r][i][2], v[r][i][3])}; *(u32x2*)(XB + (size_t)(row0 + r) * 1024 + col) = xo; }
      }
    }
  }
}

#define LDT 72
template <int NI>
DEV void gemm_kloop(const u16* __restrict__ A, int lda, const u16* __restrict__ B, int ldb, int K,
                    f32x4 (&acc)[8][NI], u16* sm, int tid, bool preloaded = false) {
  const int lane = tid & 63, w = tid >> 6, wr = w >> 2, wc = w & 3;
  const int lr = tid >> 3, lc = (tid & 7) * 8;
  const int l15 = lane & 15, quad = lane >> 4;
  constexpr int GL = 64;
  constexpr int BUFSZ = (256 + 64 * NI) * GL;
  const int lcx = ((tid & 7) ^ ((lr >> 1) & 7)) * 8;
  const unsigned oa = lr * lda + lcx, ob = lr * ldb + lcx;
  char* const lw = (char*)sm + tid * 16;
  const int pc0 = quad ^ (l15 >> 1);
  const u16* const fra = sm + (wr * 128 + l15) * GL;
  const u16* const frb = sm + 256 * GL + (wc * 16 * NI + l15) * GL;
#define G_ISSUE(BUF, KT)                                                                     \
  {                                                                                          \
    _Pragma("unroll") for (int i = 0; i < 4; ++i)                                            \
      __builtin_amdgcn_global_load_lds((const unsigned*)(A + (oa + (unsigned)(64 * i) * lda + (KT) * 64)),            \
                                       (unsigned*)(lw + (BUF) * (BUFSZ * 2) + i * 8192), 16, 0, 0);                   \
    _Pragma("unroll") for (int i = 0; i < NI; ++i)                                           \
      __builtin_amdgcn_global_load_lds((const unsigned*)(B + (ob + (unsigned)(64 * i) * ldb + (KT) * 64)),            \
                                       (unsigned*)(lw + (BUF) * (BUFSZ * 2) + 256 * 128 + i * 8192), 16, 0, 0);       \
  }
#define G_WAIT asm volatile("s_waitcnt vmcnt(0)" ::: "memory")
#define SB_ __builtin_amdgcn_sched_barrier(0)
#define LDA_(dst, BUF, ks, h) _Pragma("unroll") for (int i = 0; i < 4; ++i) dst[i] = *(const bf16x8*)(fra + (BUF) * BUFSZ + (((h) * 4 + i) * 16) * GL + ((pc0 ^ ((ks) * 4)) * 8))
#define LDB_(dst, BUF, ks) _Pragma("unroll") for (int i = 0; i < NI; ++i) dst[i] = *(const bf16x8*)(frb + (BUF) * BUFSZ + (i * 16) * GL + ((pc0 ^ ((ks) * 4)) * 8))
#define MM_(a, b, h) _Pragma("unroll") for (int i = 0; i < 4; ++i) _Pragma("unroll") for (int ni = 0; ni < NI; ++ni) \
    acc[(h) * 4 + i][ni] = __builtin_amdgcn_mfma_f32_16x16x32_bf16(b[ni], a[i], acc[(h) * 4 + i][ni], 0, 0, 0)
#define G_COMPUTE(BUF)                                                                       \
  {                                                                                          \
    bf16x8 a0[4], a1[4], b0[NI];                                                             \
    LDA_(a0, BUF, 0, 0); LDB_(b0, BUF, 0); LDA_(a1, BUF, 0, 1); SB_;                         \
    MM_(a0, b0, 0); SB_;                                                                     \
    LDA_(a0, BUF, 1, 0); SB_;                                                                \
    MM_(a1, b0, 1); SB_;                                                                     \
    LDB_(b0, BUF, 1); LDA_(a1, BUF, 1, 1); SB_;                                              \
    MM_(a0, b0, 0); SB_;                                                                     \
    MM_(a1, b0, 1); SB_;                                                                     \
  }
  const int nk = K >> 6;
  if (!preloaded) {
    lds_barrier();
    G_ISSUE(0, 0);
  }
  G_WAIT;
  lds_barrier();
  for (int kt = 0; kt < nk; kt += 2) {
    G_ISSUE(1, kt + 1);
    G_COMPUTE(0);
    G_WAIT;
    lds_barrier();
    G_ISSUE(0, min(kt + 2, nk - 1));
    G_COMPUTE(1);
    G_WAIT;
    lds_barrier();
  }
#undef G_ISSUE
#undef G_WAIT
#undef G_COMPUTE
#undef SB_
#undef LDA_
#undef LDB_
#undef MM_
}

template <int NI>
DEV void gemm_issue_first(const u16* __restrict__ A, int lda, const u16* __restrict__ B, int ldb, u16* sm, int tid) {
  const int lr = tid >> 3;
  const int lcx = ((tid & 7) ^ ((lr >> 1) & 7)) * 8;
  const unsigned oa = lr * lda + lcx, ob = lr * ldb + lcx;
  char* const lw = (char*)sm + tid * 16;
#pragma unroll
  for (int i = 0; i < 4; ++i)
    __builtin_amdgcn_global_load_lds((const unsigned*)(A + (oa + (unsigned)(64 * i) * lda)), (unsigned*)(lw + i * 8192), 16, 0, 0);
#pragma unroll
  for (int i = 0; i < NI; ++i)
    __builtin_amdgcn_global_load_lds((const unsigned*)(B + (ob + (unsigned)(64 * i) * ldb)), (unsigned*)(lw + 256 * 128 + i * 8192), 16, 0, 0);
}

DEV int tile_for(int it, int nM, int nN, int& tm, int& tn, int PNreq = 0) {
  const int G = gridDim.x;
  if ((G & 63) == 0) {
    const int nslots = G >> 3;
    const int PN = (PNreq > 0 && nslots % PNreq == 0) ? PNreq : (nslots >> 3);
    const int PM = nslots / PN;
    const int xcd = blockIdx.x & 7, slot = blockIdx.x >> 3;
    const int dm = slot / PN, dn = slot % PN;
    const int npn = (nN + PN - 1) / PN, npm = (nM + PM - 1) / PM;
    const int per = (npm * npn + 7) >> 3;
    const int pch = xcd * per + it;
    if (it >= per || pch >= npm * npn) return -1;
    tm = (pch / npn) * PM + dm;
    tn = (pch % npn) * PN + dn;
    return (tm < nM && tn < nN) ? 1 : 0;
  } else {
    int t = blockIdx.x + it * G;
    if (t >= nM * nN) return -1;
    tm = t / nN; tn = t % nN;
    return 1;
  }
}

DEV void phase_gemm_store(const u16* A, int lda, const u16* Bt, int ldb, int K, int nN, u16* C, int ldc, u16* sm, PP p, int l, bool fuse_post) {
  const int tid = ftid();
  const int lane = tid & 63, w = tid >> 6, wr = w >> 2, wc = w & 3, l15 = lane & 15, quad = lane >> 4;
  bool pre = false;
  for (int it = 0;; ++it) {
    int tm, tn;
    int r = tile_for(it, 64, nN, tm, tn, 8);
    if (r < 0) break;
    if (r == 0) { pre = false; continue; }
    int ntm = 0, ntn = 0;
    const bool has_next = tile_for(it + 1, 64, nN, ntm, ntn, 8) == 1;
    f32x4 acc[8][4];
#pragma unroll
    for (int i = 0; i < 8; ++i)
#pragma unroll
      for (int j = 0; j < 4; ++j) acc[i][j] = f32x4{0.f, 0.f, 0.f, 0.f};
    gemm_kloop<4>(A + (size_t)tm * 256 * lda, lda, Bt + (size_t)tn * 256 * ldb, ldb, K, acc, sm, tid, pre);
    if (fuse_post && tn < 6) {
      int tn_ = tn, tm_ = tm, wc_ = wc, quad_ = quad, l15_ = l15, wr_ = wr;
      asm volatile("" : "+s"(tn_), "+s"(tm_));
      asm volatile("" : "+v"(wc_), "+v"(quad_), "+v"(l15_), "+v"(wr_));
      const int tn = tn_, tm = tm_, wc = __builtin_amdgcn_readfirstlane(wc_), quad = quad_, l15 = l15_, wr = __builtin_amdgcn_readfirstlane(wr_);
      const bool sample = tm >= 32;
      const bool is_v = (tn == 2) || (tn == 5 && wc >= 2);
      const bool rope = sample && (tn == 3 || tn == 4 || (tn == 5 && wc < 2));
      const float* wn = p->in[tn == 0 ? 15 : tn == 1 ? 16 : tn == 5 ? 19 : 18] + l * 64 + quad * 4;
      float* outb = nullptr; int ostride = 0;
      if (!sample) {
        if (tn == 1) { outb = p->out + OUT_NAK + wc * 64; ostride = 256; }
        else if (tn == 2) { outb = p->out + OUT_NAV + wc * 64; ostride = 256; }
        else if (tn == 5) { outb = p->out + (wc < 2 ? OUT_GQK : OUT_GQV) + (wc & 1) * 64; ostride = 128; }
      }
      float invf[4];
#pragma unroll
      for (int j = 0; j < 4; ++j) invf[j] = exp2f(-(float)(quad * 4 + j) * 0.83048202372184058696f);
#pragma unroll
      for (int mi = 0; mi < 8; ++mi) {
        const int m = tm * 256 + wr * 128 + mi * 16 + l15;
        if (!is_v) {
          float ss = 0.f;
#pragma unroll
          for (int ni = 0; ni < 4; ++ni)
#pragma unroll
            for (int j = 0; j < 4; ++j) ss += acc[mi][ni][j] * acc[mi][ni][j];
          ss += __shfl_xor(ss, 16);
          ss += __shfl_xor(ss, 32);
          const float rstd = rsqrtf(ss * (1.f / 64.f) + 1e-6f);
#pragma unroll
          for (int ni = 0; ni < 4; ++ni) {
            const f32x4 wv = *(const f32x4*)(wn + ni * 16);
            acc[mi][ni] = acc[mi][ni] * rstd * wv;
          }
          if (rope) {
            const int t = (m - 8192) & 4095;
            const float gr = (float)(t >> 6), gc = (float)(t & 63);
#pragma unroll
            for (int j = 0; j < 4; ++j) {
              const float aA = gr * invf[j], aB = gc * invf[j];
              const float cA = __cosf(aA), sA = __sinf(aA), cB = __cosf(aB), sB = __sinf(aB);
              const float x1 = acc[mi][0][j], x2 = acc[mi][2][j];
              acc[mi][0][j] = x1 * cA - x2 * sA; acc[mi][2][j] = x1 * sA + x2 * cA;
              const float y1 = acc[mi][1][j], y2 = acc[mi][3][j];
              acc[mi][1][j] = y1 * cB - y2 * sB; acc[mi][3][j] = y1 * sB + y2 * cB;
            }
          }
        }
        if (outb) {
          const int t = m & 255;
          float* orow = outb + ((size_t)(tm * 4 + l) * 256 + t) * ostride + quad * 4;
#pragma unroll
          for (int ni = 0; ni < 4; ++ni) *(f32x4*)(orow + ni * 16) = acc[mi][ni];
        }
        __builtin_amdgcn_sched_barrier(0);
      }
    }
    {
      unsigned char* cl = (unsigned char*)sm;
      int t2 = tid;
      asm volatile("" : "+v"(t2));
      const int wr = t2 >> 8, wc = (t2 >> 6) & 3, l15 = t2 & 15, quad = (t2 >> 4) & 3;
#pragma unroll
      for (int mi = 0; mi < 8; ++mi) {
        const int row = wr * 128 + mi * 16 + l15;
#pragma unroll
        for (int ni = 0; ni < 4; ++ni) {
          const int col = wc * 64 + ni * 16 + quad * 4;
          u32x2 o = {pack2(acc[mi][ni][0], acc[mi][ni][1]), pack2(acc[mi][ni][2], acc[mi][ni][3])};
          *(u32x2*)(cl + row * 520 + col * 2) = o;
        }
      }
      lds_barrier();
      const int rr = t2 >> 5, cc = t2 & 31;
      const bool do_pf = has_next && !(fuse_post && (tn == 2 || tn == 5));
#pragma unroll
      for (int q = 0; q < 8; ++q) {
        const int row = q * 16 + rr;
        const u32x2 lo = *(const u32x2*)(cl + row * 520 + cc * 16);
        const u32x2 hi = *(const u32x2*)(cl + row * 520 + cc * 16 + 8);
        const u32x4 o = {lo.x, lo.y, hi.x, hi.y};
        *(u32x4*)(C + (size_t)(tm * 256 + row) * ldc + tn * 256 + cc * 8) = o;
      }
      if (do_pf) {
        lds_barrier();
        gemm_issue_first<4>(A + (size_t)ntm * 256 * lda, lda, Bt + (size_t)ntn * 256 * ldb, ldb, sm, tid);
      }
      pre = do_pf;
#pragma unroll
      for (int q = 8; q < 16; ++q) {
        const int row = q * 16 + rr;
        const u32x2 lo = *(const u32x2*)(cl + row * 520 + cc * 16);
        const u32x2 hi = *(const u32x2*)(cl + row * 520 + cc * 16 + 8);
        const u32x4 o = {lo.x, lo.y, hi.x, hi.y};
        *(u32x4*)(C + (size_t)(tm * 256 + row) * ldc + tn * 256 + cc * 8) = o;
      }
      if (fuse_post && (tn == 2 || tn == 5)) {
        const bool sample = tm >= 32;
        const int ncol = tn == 2 ? 256 : 128, cbase = tn == 2 ? 0 : 128;
        const int T = sample ? LDVS : 256;
        const int sb = (tm - 32) >> 4, t0 = sample ? ((tm - 32) & 15) * 256 : 0;
        u16* vt;
        if (tn == 2) vt = (u16*)(p->ws + (sample ? OFF_VTA_S : OFF_VTA_P)) + (size_t)(sample ? sb : tm) * 4 * 64 * T;
        else         vt = (u16*)(p->ws + (sample ? OFF_VTB_S : OFF_VTB_P)) + (size_t)(sample ? sb : tm) * 2 * 64 * T;
        const int nunits = ncol * 32;
        for (int u = t2; u < nunits; u += 512) {
          const int cidx = u & (ncol - 1), chunk = u / ncol;
          const unsigned char* src = cl + (chunk * 8) * 520 + (cbase + cidx) * 2;
          unsigned o[4];
#pragma unroll
          for (int j = 0; j < 4; ++j) {
            const unsigned a = *(const u16*)(src + (2 * j) * 520);
            const unsigned b2 = *(const u16*)(src + (2 * j + 1) * 520);
            o[j] = a | (b2 << 16);
          }
          *(u32x4*)(vt + (size_t)cidx * T + t0 + chunk * 8) = u32x4{o[0], o[1], o[2], o[3]};
        }
      }
    }
  }
}

DEV void conv_rows(const unsigned char* cl, int row_base, int t2, int tm, int tn, u16* ACT, const float* cw, const float* cb) {
  const int cg8 = (t2 & 15) * 8, rb = row_base + (t2 >> 4) * 4;
  const int ca = tn * 128 + cg8;
  float wa[3][8], wg[3][8], ba[8], bg[8];
#pragma unroll
  for (int j = 0; j < 3; ++j) {
    const f32x4 t0 = *(const f32x4*)(cw + j * 5632 + ca), t1 = *(const f32x4*)(cw + j * 5632 + ca + 4);
    const f32x4 t2v = *(const f32x4*)(cw + j * 5632 + 2816 + ca), t3 = *(const f32x4*)(cw + j * 5632 + 2816 + ca + 4);
#pragma unroll
    for (int q = 0; q < 4; ++q) { wa[j][q] = t0[q]; wa[j][4 + q] = t1[q]; wg[j][q] = t2v[q]; wg[j][4 + q] = t3[q]; }
  }
  {
    const f32x4 t0 = *(const f32x4*)(cb + ca), t1 = *(const f32x4*)(cb + ca + 4);
    const f32x4 t2v = *(const f32x4*)(cb + 2816 + ca), t3 = *(const f32x4*)(cb + 2816 + ca + 4);
#pragma unroll
    for (int q = 0; q < 4; ++q) { ba[q] = t0[q]; ba[4 + q] = t1[q]; bg[q] = t2v[q]; bg[4 + q] = t3[q]; }
  }
  u32x4 ra[6], rg[6];
  const u32x4 zero4 = {0u, 0u, 0u, 0u};
#pragma unroll
  for (int i = 0; i < 6; ++i) {
    const int row = rb - 1 + i;
    const bool ok = row >= 0 && row < 256;
    const unsigned char* src = cl + (ok ? row : 0) * 520 + cg8 * 2;
    const u32x2 a0 = *(const u32x2*)(src), a1 = *(const u32x2*)(src + 8);
    const u32x2 g0 = *(const u32x2*)(src + 256), g1 = *(const u32x2*)(src + 264);
    ra[i] = ok ? u32x4{a0.x, a0.y, a1.x, a1.y} : zero4;
    rg[i] = ok ? u32x4{g0.x, g0.y, g1.x, g1.y} : zero4;
  }
#pragma unroll
  for (int i = 0; i < 4; ++i) {
    u32x4 o;
#pragma unroll
    for (int q = 0; q < 4; ++q) {
      const float a0 = ba[2 * q] + lo2f(ra[i][q]) * wa[0][2 * q] + lo2f(ra[i + 1][q]) * wa[1][2 * q] + lo2f(ra[i + 2][q]) * wa[2][2 * q];
      const float a1 = ba[2 * q + 1] + hi2f(ra[i][q]) * wa[0][2 * q + 1] + hi2f(ra[i + 1][q]) * wa[1][2 * q + 1] + hi2f(ra[i + 2][q]) * wa[2][2 * q + 1];
      const float g0 = bg[2 * q] + lo2f(rg[i][q]) * wg[0][2 * q] + lo2f(rg[i + 1][q]) * wg[1][2 * q] + lo2f(rg[i + 2][q]) * wg[2][2 * q];
      const float g1 = bg[2 * q + 1] + hi2f(rg[i][q]) * wg[0][2 * q + 1] + hi2f(rg[i + 1][q]) * wg[1][2 * q + 1] + hi2f(rg[i + 2][q]) * wg[2][2 * q + 1];
      o[q] = pack2(a0 * silu_f(g0), a1 * silu_f(g1));
    }
    *(u32x4*)(ACT + (size_t)(tm * 256 + rb + i) * LDACT + ca) = o;
  }
}

DEV void phase_gemm_up_conv(PP p, int l, u16* sm) {
  const int tid = ftid();
  const u16* A = (const u16*)(p->ws + OFF_H);
  const u16* Bt = (const u16*)(p->ws + OFF_WT_UP);
  u16* ACT = (u16*)(p->ws + OFF_ACT);
  u16* HALO = (u16*)(p->ws + OFF_OA);
  const float* cw = p->in[28] + (size_t)l * 3 * 5632;
  const float* cb = p->in[29] + (size_t)l * 5632;
  bool pre = false;
  for (int it = 0;; ++it) {
    int tm, tn;
    int r = tile_for(it, 64, 22, tm, tn, 8);
    if (r < 0) break;
    if (r == 0) { pre = false; continue; }
    int ntm = 0, ntn = 0;
    const bool has_next = tile_for(it + 1, 64, 22, ntm, ntn, 8) == 1;
    f32x4 acc[8][4];
#pragma unroll
    for (int i = 0; i < 8; ++i)
#pragma unroll
      for (int j = 0; j < 4; ++j) acc[i][j] = f32x4{0.f, 0.f, 0.f, 0.f};
    gemm_kloop<4>(A + (size_t)tm * 256 * LDH, LDH, Bt + (size_t)tn * 256 * LDW1, LDW1, 1024, acc, sm, tid, pre);
    {
      unsigned char* cl = (unsigned char*)sm;
      int t2 = tid;
      asm volatile("" : "+v"(t2));
      const int wr = t2 >> 8, wc = (t2 >> 6) & 3, l15 = t2 & 15, quad = (t2 >> 4) & 3;
#pragma unroll
      for (int mi = 0; mi < 8; ++mi) {
        const int row = wr * 128 + mi * 16 + l15;
#pragma unroll
        for (int ni = 0; ni < 4; ++ni) {
          const int col = wc * 64 + ni * 16 + quad * 4;
          u32x2 o = {pack2(acc[mi][ni][0], acc[mi][ni][1]), pack2(acc[mi][ni][2], acc[mi][ni][3])};
          *(u32x2*)(cl + row * 520 + col * 2) = o;
        }
      }
      lds_barrier();
      if (t2 < 128) {
        const int hr = t2 >> 5, chunk = t2 & 31;
        const int row = hr < 2 ? hr : 252 + hr;
        const unsigned char* src = cl + row * 520 + chunk * 16;
        const u32x2 lo = *(const u32x2*)(src), hi = *(const u32x2*)(src + 8);
        const int dcol = chunk < 16 ? tn * 128 + chunk * 8 : 2816 + tn * 128 + (chunk - 16) * 8;
        *(u32x4*)(HALO + ((size_t)(tm * 4 + hr)) * 5632 + dcol) = u32x4{lo.x, lo.y, hi.x, hi.y};
      }
      conv_rows(cl, 0, t2, tm, tn, ACT, cw, cb);
      if (has_next) {
        lds_barrier();
        gemm_issue_first<4>(A + (size_t)ntm * 256 * LDH, LDH, Bt + (size_t)ntn * 256 * LDW1, LDW1, sm, tid);
      }
      pre = has_next;
      conv_rows(cl, 128, t2, tm, tn, ACT, cw, cb);
    }
  }
}

DEV void conv_fix_rows(PP p, int l, int tm, int t2) {
  if (tm < 32) return;
  const int ts = (tm - 32) & 15;
  const u16* HALO = (const u16*)(p->ws + OFF_OA);
  u16* ACT = (u16*)(p->ws + OFF_ACT);
  const float* cw = p->in[28] + (size_t)l * 3 * 5632;
  const float* cb = p->in[29] + (size_t)l * 5632;
  for (int u = t2; u < 704; u += 512) {
    const int last = u >= 352, c0 = (last ? u - 352 : u) * 8;
    if (last ? (ts == 15) : (ts == 0)) continue;
    const u16* hp = last ? HALO + (size_t)(tm * 4 + 2) * 5632 : HALO + (size_t)((tm - 1) * 4 + 3) * 5632;
    const u16* hc = last ? HALO + (size_t)(tm * 4 + 3) * 5632 : HALO + (size_t)(tm * 4 + 0) * 5632;
    const u16* hn = last ? HALO + (size_t)((tm + 1) * 4 + 0) * 5632 : HALO + (size_t)(tm * 4 + 1) * 5632;
    const u32x4 pa = *(const u32x4*)(hp + c0), pg = *(const u32x4*)(hp + 2816 + c0);
    const u32x4 ca = *(const u32x4*)(hc + c0), cgv = *(const u32x4*)(hc + 2816 + c0);
    const u32x4 na = *(const u32x4*)(hn + c0), ng = *(const u32x4*)(hn + 2816 + c0);
    u32x4 o;
#pragma unroll
    for (int q = 0; q < 4; ++q) {
      const int c = c0 + 2 * q;
      const float a0 = cb[c] + lo2f(pa[q]) * cw[c] + lo2f(ca[q]) * cw[5632 + c] + lo2f(na[q]) * cw[2 * 5632 + c];
      const float a1 = cb[c + 1] + hi2f(pa[q]) * cw[c + 1] + hi2f(ca[q]) * cw[5632 + c + 1] + hi2f(na[q]) * cw[2 * 5632 + c + 1];
      const float g0 = cb[2816 + c] + lo2f(pg[q]) * cw[2816 + c] + lo2f(cgv[q]) * cw[5632 + 2816 + c] + lo2f(ng[q]) * cw[2 * 5632 + 2816 + c];
      const float g1 = cb[2816 + c + 1] + hi2f(pg[q]) * cw[2816 + c + 1] + hi2f(cgv[q]) * cw[5632 + 2816 + c + 1] + hi2f(ng[q]) * cw[2 * 5632 + 2816 + c + 1];
      o[q] = pack2(a0 * silu_f(g0), a1 * silu_f(g1));
    }
    *(u32x4*)(ACT + (size_t)(tm * 256 + (last ? 255 : 0)) * LDACT + c0) = o;
  }
}

DEV void phase_gemm_resid(const u16* A, int lda, const u16* Bt, int ldb, int K, u16* XB, const float* gate_l, u16* sm, float* final_out,
                          PP pfix = nullptr, int lfix = 0) {
  const int tid = ftid();
  const int lane = tid & 63, w = tid >> 6, wr = w >> 2, wc = w & 3, l15 = lane & 15, quad = lane >> 4;
  for (int it = 0;; ++it) {
    int tm, tn;
    int r = tile_for(it, 64, 4, tm, tn);
    if (r < 0) break;
    if (r == 0) continue;
    f32x4 acc[8][4];
#pragma unroll
    for (int i = 0; i < 8; ++i)
#pragma unroll
      for (int j = 0; j < 4; ++j) acc[i][j] = f32x4{0.f, 0.f, 0.f, 0.f};
    if (pfix) {
      conv_fix_rows(pfix, lfix, tm, tid);
      asm volatile("s_waitcnt vmcnt(0)" ::: "memory");
      __syncthreads();
    }
    gemm_kloop<4>(A + (size_t)tm * 256 * lda, lda, Bt + (size_t)tn * 256 * ldb, ldb, K, acc, sm, tid);
    const float* gt = gate_l + cond_of(tm * 256) * 6144;
#pragma unroll
    for (int ni = 0; ni < 4; ++ni) {
      const int n = tn * 256 + wc * 64 + ni * 16 + quad * 4;
      const f32x4 gg = *(const f32x4*)(gt + n);
#pragma unroll
      for (int mi = 0; mi < 8; ++mi) {
        const int m = tm * 256 + wr * 128 + mi * 16 + l15;
        u32x2* xp = (u32x2*)(XB + (size_t)m * 1024 + n);
        const u32x2 xq = *xp;
        f32x4 x = {lo2f(xq.x), hi2f(xq.x), lo2f(xq.y), hi2f(xq.y)};
        x += gg * acc[mi][ni];
        if (final_out) *(f32x4*)(final_out + (size_t)m * 1024 + n) = x;
        else { const u32x2 xo = {pack2(x[0], x[1]), pack2(x[2], x[3])}; *xp = xo; }
      }
    }
  }
}

DEV void phase_gemm_merge(PP p, u16* sm) {
  const int tid = ftid();
  const int lane = tid & 63, w = tid >> 6, wr = w >> 2, wc = w & 3, l15 = lane & 15, quad = lane >> 4;
  const u16* PROJ = (const u16*)(p->ws + OFF_PROJ);
  u16* MG = (u16*)(p->ws + OFF_H);
  for (int it = 0;; ++it) {
    int tm, tn;
    int r = tile_for(it, 64, 8, tm, tn);
    if (r < 0) break;
    if (r == 0) continue;
    f32x4 tot[8][2];
#pragma unroll
    for (int i = 0; i < 8; ++i)
#pragma unroll
      for (int j = 0; j < 2; ++j) tot[i][j] = f32x4{0.f, 0.f, 0.f, 0.f};
#pragma unroll 1
    for (int br = 0; br < 3; ++br) {
      const u16* A = (const u16*)(p->ws + (br == 0 ? OFF_OA : br == 1 ? OFF_OB : OFF_OC));
      const u16* Bt = (const u16*)(p->ws + (br == 0 ? OFF_WT_A : br == 1 ? OFF_WT_B : OFF_WT_C));
      const int K = br == 1 ? 512 : 256;
      const int gcol = br == 0 ? C_GA : br == 1 ? C_GB : C_GC;
      f32x4 acc[8][2];
#pragma unroll
      for (int i = 0; i < 8; ++i)
#pragma unroll
        for (int j = 0; j < 2; ++j) acc[i][j] = f32x4{0.f, 0.f, 0.f, 0.f};
      gemm_kloop<2>(A + (size_t)tm * 256 * K, K, Bt + (size_t)tn * 128 * K, K, K, acc, sm, tid);
#pragma unroll
      for (int mi = 0; mi < 8; ++mi) {
        const int m = tm * 256 + wr * 128 + mi * 16 + l15;
#pragma unroll
        for (int ni = 0; ni < 2; ++ni) {
          const int n = tn * 128 + wc * 32 + ni * 16 + quad * 4;
          const u32x2 gq = *(const u32x2*)(PROJ + (size_t)m * NP + gcol + n);
          tot[mi][ni][0] += sigm_f(lo2f(gq.x)) * acc[mi][ni][0];
          tot[mi][ni][1] += sigm_f(hi2f(gq.x)) * acc[mi][ni][1];
          tot[mi][ni][2] += sigm_f(lo2f(gq.y)) * acc[mi][ni][2];
          tot[mi][ni][3] += sigm_f(hi2f(gq.y)) * acc[mi][ni][3];
        }
      }
    }
#pragma unroll
    for (int mi = 0; mi < 8; ++mi) {
      const int m = tm * 256 + wr * 128 + mi * 16 + l15;
#pragma unroll
      for (int ni = 0; ni < 2; ++ni) {
        const int n = tn * 128 + wc * 32 + ni * 16 + quad * 4;
        u32x2 o = {pack2(tot[mi][ni][0], tot[mi][ni][1]), pack2(tot[mi][ni][2], tot[mi][ni][3])};
        *(u32x2*)(MG + (size_t)m * LDH + n) = o;
      }
    }
  }
}

DEV void gla_g1_item(PP p, int l, int tb, int h, float* sm) {
  float* ZF = sm;
  float* ZB = sm + 1024;
  float* LF = sm + 2048;
  float* LB = LF + 4096;
  float* TOT = LB + 4096;
  float* OFS = TOT + 512;
  u16* KFT = (u16*)(sm + 11392);
  u16* KBT = KFT + 64 * 72;
  u16* VT = KBT + 64 * 72;
  const int tid = otid();
  const int r0 = tb * 64;
  const u16* PROJ = (const u16*)(p->ws + OFF_PROJ);
  float* CUMF = (float*)(p->ws + OFF_CUMF);
  float* CUMB = (float*)(p->ws + OFF_CUMB);
  float wf[16], wb[16];
  float kreg[16];
  const int gd = tid & 63;
  const float* wg = p->in[20] + (size_t)l * 2 * 16 * 256 + h * 64 + gd;
#pragma unroll
  for (int r = 0; r < 16; ++r) { wf[r] = wg[r * 256]; wb[r] = wg[16 * 256 + r * 256]; }
  const float bf = p->in[21][l * 512 + h * 64 + gd], bb = p->in[21][l * 512 + 256 + h * 64 + gd];
#pragma unroll
  for (int j = 0; j < 16; ++j) {
    const int t = (tid >> 6) + 4 * j;
    kreg[j] = bf2f(PROJ[(size_t)(r0 + t) * NP + C_KC + h * 64 + gd]);
  }
  __syncthreads();
  {
    const int t = tid >> 2, c8 = (tid & 3) * 8;
    const u32x4 zq = *(const u32x4*)(PROJ + (size_t)(r0 + t) * NP + C_ZF + c8);
    float* zd = (c8 < 16) ? (ZF + t * 16 + c8) : (ZB + t * 16 + c8 - 16);
    *(f32x4*)(zd) = f32x4{lo2f(zq[0]), hi2f(zq[0]), lo2f(zq[1]), hi2f(zq[1])};
    *(f32x4*)(zd + 4) = f32x4{lo2f(zq[2]), hi2f(zq[2]), lo2f(zq[3]), hi2f(zq[3])};
  }
#pragma unroll
  for (int k = 0; k < 4; ++k) {
    const int u = tid + 256 * k, t = u >> 4, v4 = (u & 15) * 4;
    const u32x2 q = *(const u32x2*)(PROJ + (size_t)(r0 + t) * NP + C_VC + h * 64 + v4);
    VT[(v4 + 0) * 72 + t] = (u16)(q.x & 0xffffu);
    VT[(v4 + 1) * 72 + t] = (u16)(q.x >> 16);
    VT[(v4 + 2) * 72 + t] = (u16)(q.y & 0xffffu);
    VT[(v4 + 3) * 72 + t] = (u16)(q.y >> 16);
  }
  __syncthreads();
  {
    const int d = tid & 63, tg = tid >> 6;
    float accF = 0.f, accB = 0.f;
    for (int i = 0; i < 16; ++i) {
      const int tf = tg * 16 + i, tbk = tg * 16 + 15 - i;
      float af = bf, ab = bb;
#pragma unroll
      for (int r = 0; r < 16; ++r) { af += ZF[tf * 16 + r] * wf[r]; ab += ZB[tbk * 16 + r] * wb[r]; }
      accF += logsig_f(af) * (1.f / 16.f);
      accB += logsig_f(ab) * (1.f / 16.f);
      LF[tf * 64 + d] = accF;
      LB[tbk * 64 + d] = accB;
    }
    TOT[tg * 64 + d] = accF;
    TOT[256 + tg * 64 + d] = accB;
  }
  __syncthreads();
  {
    const int d = tid & 63, tg = tid >> 6;
    float oF = 0.f, oB = 0.f, tF = 0.f, tB = 0.f;
#pragma unroll
    for (int g = 0; g < 4; ++g) {
      const float a = TOT[g * 64 + d], b = TOT[256 + g * 64 + d];
      tF += a; tB += b;
      oF += (g < tg) ? a : 0.f;
      oB += (g > tg) ? b : 0.f;
    }
    OFS[tg * 64 + d] = oF;
    OFS[256 + tg * 64 + d] = oB;
    if (tg == 0) { OFS[512 + d] = tF; OFS[576 + d] = tB; }
  }
  __syncthreads();
  const int gi = tb * 4 + h;
  const float totF = OFS[512 + (tid & 63)], totB = OFS[576 + (tid & 63)];
  if (tid < 64) {
    ((float*)(p->ws + OFF_DF))[gi * 64 + tid] = __expf(totF);
    ((float*)(p->ws + OFF_DB))[gi * 64 + tid] = __expf(totB);
  }
#pragma unroll
  for (int j = 0; j < 16; ++j) {
    const int i = tid + 256 * j;
    const int t = i >> 6, d = i & 63;
    const float cf = LF[i] + OFS[(t >> 4) * 64 + d];
    const float cb = LB[i] + OFS[256 + (t >> 4) * 64 + d];
    CUMF[(size_t)(r0 + t) * 256 + h * 64 + d] = cf;
    CUMB[(size_t)(r0 + t) * 256 + h * 64 + d] = cb;
    const float k = kreg[j];
    KFT[d * 72 + t] = f2bf(k * __expf(totF - cf));
    KBT[d * 72 + t] = f2bf(k * __expf(totB - cb));
  }
  __syncthreads();
  {
    const int lane = tid & 63, w = tid >> 6, quad = lane >> 4, l15 = lane & 15;
    const bf16x8 kf0 = *(const bf16x8*)(KFT + (16 * w + l15) * 72 + quad * 8);
    const bf16x8 kf1 = *(const bf16x8*)(KFT + (16 * w + l15) * 72 + 32 + quad * 8);
    const bf16x8 kb0 = *(const bf16x8*)(KBT + (16 * w + l15) * 72 + quad * 8);
    const bf16x8 kb1 = *(const bf16x8*)(KBT + (16 * w + l15) * 72 + 32 + quad * 8);
    u16* KVF = (u16*)(p->ws + OFF_KVF) + (size_t)gi * 4096;
    u16* KVB = (u16*)(p->ws + OFF_KVB) + (size_t)gi * 4096;
    const int d = 16 * w + l15;
#pragma unroll
    for (int vt = 0; vt < 4; ++vt) {
      const bf16x8 v0 = *(const bf16x8*)(VT + (vt * 16 + l15) * 72 + quad * 8);
      const bf16x8 v1 = *(const bf16x8*)(VT + (vt * 16 + l15) * 72 + 32 + quad * 8);
      f32x4 af = f32x4{0.f, 0.f, 0.f, 0.f}, ab = f32x4{0.f, 0.f, 0.f, 0.f};
      af = __builtin_amdgcn_mfma_f32_16x16x32_bf16(v0, kf0, af, 0, 0, 0);
      af = __builtin_amdgcn_mfma_f32_16x16x32_bf16(v1, kf1, af, 0, 0, 0);
      ab = __builtin_amdgcn_mfma_f32_16x16x32_bf16(v0, kb0, ab, 0, 0, 0);
      ab = __builtin_amdgcn_mfma_f32_16x16x32_bf16(v1, kb1, ab, 0, 0, 0);
      const u32x2 of = {pack2(af[0], af[1]), pack2(af[2], af[3])};
      const u32x2 ob = {pack2(ab[0], ab[1]), pack2(ab[2], ab[3])};
      *(u32x2*)(KVF + d * 64 + vt * 16 + quad * 4) = of;
      *(u32x2*)(KVB + d * 64 + vt * 16 + quad * 4) = ob;
    }
  }
}

template <int CH>
DEV void gla_g2_scan(u16* KV, const float* DC, int tb0, int N, int h, int dir, int e, int d, f32x4& S) {
  for (int m0 = 0; m0 < N; m0 += CH) {
    u32x2 kv[CH]; float dc[CH];
#pragma unroll
    for (int j = 0; j < CH; ++j) {
      const int m = dir ? (N - 1 - (m0 + j)) : (m0 + j);
      const int gi = (tb0 + m) * 4 + h;
      kv[j] = *(const u32x2*)(KV + (size_t)gi * 4096 + e);
      dc[j] = DC[gi * 64 + d];
    }
#pragma unroll
    for (int j = 0; j < CH; ++j) {
      const int m = dir ? (N - 1 - (m0 + j)) : (m0 + j);
      const int gi = (tb0 + m) * 4 + h;
      const u32x2 so = {pack2(S[0], S[1]), pack2(S[2], S[3])};
      *(u32x2*)(KV + (size_t)gi * 4096 + e) = so;
      const f32x4 kf = {lo2f(kv[j].x), hi2f(kv[j].x), lo2f(kv[j].y), hi2f(kv[j].y)};
      S = S * dc[j] + kf;
    }
  }
}
DEV void gla_g2_item(PP p, int l, int item) {
  const int tid = otid();
  const int quarter = item & 3, dir = (item >> 2) & 1, h = (item >> 3) & 3, seq = item >> 5;
  const int e = quarter * 1024 + tid * 4, d = e >> 6;
  u16* KV = (u16*)(p->ws + (dir ? OFF_KVB : OFF_KVF));
  const float* DC = (const float*)(p->ws + (dir ? OFF_DB : OFF_DF));
  f32x4 S = {0.f, 0.f, 0.f, 0.f};
  if (seq < 32) {
    gla_g2_scan<4>(KV, DC, seq * 4, 4, h, dir, e, d, S);
    *(f32x4*)(p->out + (dir ? OUT_GLB : OUT_GLF) + ((size_t)(seq * 4 + l) * 4 + h) * 4096 + e) = S;
  } else {
    const int b = seq - 32;
    S = *(const f32x4*)(p->in[dir ? 7 : 6] + ((size_t)(b * 4 + l) * 4 + h) * 4096 + e);
    gla_g2_scan<32>(KV, DC, 128 + b * 64, 64, h, dir, e, d, S);
  }
}

#define GT 72
DEV void gla_g3_item(PP p, int l, int tb, int h, u16* sm) {
  u16* QH = sm;
  u16* KH = sm + 64 * GT;
  u16* VT = KH + 64 * GT;
  u16* ST = VT + 64 * GT;
  const int tid = otid(), lane = tid & 63, w = tid >> 6, quad = lane >> 4, l15 = lane & 15;
  const int r0 = tb * 64, gi = tb * 4 + h;
  const u16* PROJ = (const u16*)(p->ws + OFF_PROJ);
  u32x2 gv[4], gq[4], gk[4], gsF[4], gsB[4];
  f32x4 gcF[4], gcB[4];
  {
    const float* CF = (const float*)(p->ws + OFF_CUMF);
    const float* CB = (const float*)(p->ws + OFF_CUMB);
    const u16* SF = (const u16*)(p->ws + OFF_KVF) + (size_t)gi * 4096;
    const u16* SB = (const u16*)(p->ws + OFF_KVB) + (size_t)gi * 4096;
#pragma unroll
    for (int k = 0; k < 4; ++k) {
      const int u = tid + 256 * k, t = u >> 4, c4 = (u & 15) * 4;
      const u16* prow = PROJ + (size_t)(r0 + t) * NP + h * 64 + c4;
      gv[k] = *(const u32x2*)(prow + C_VC);
      gq[k] = *(const u32x2*)(prow + C_QC);
      gk[k] = *(const u32x2*)(prow + C_KC);
      gcF[k] = *(const f32x4*)(CF + (size_t)(r0 + t) * 256 + h * 64 + c4);
      gcB[k] = *(const f32x4*)(CB + (size_t)(r0 + t) * 256 + h * 64 + c4);
      gsF[k] = *(const u32x2*)(SF + t * 64 + c4);
      gsB[k] = *(const u32x2*)(SB + t * 64 + c4);
    }
  }
  u32x2 grq[4];
  f32x4 gg4[4];
  {
    const int erow = r0 + 16 * w + l15;
    const float* gn = p->in[22] + l * 64;
#pragma unroll
    for (int vt = 0; vt < 4; ++vt) {
      const int v = vt * 16 + quad * 4;
      gg4[vt] = *(const f32x4*)(gn + v);
      grq[vt] = *(const u32x2*)(PROJ + (size_t)erow * NP + C_RC + h * 64 + v);
    }
  }
  __syncthreads();
#pragma unroll
  for (int k = 0; k < 4; ++k) {
    const int u = tid + 256 * k, t = u >> 4, v4 = (u & 15) * 4;
    const u32x2 q = gv[k];
    VT[(v4 + 0) * GT + t] = (u16)(q.x & 0xffffu);
    VT[(v4 + 1) * GT + t] = (u16)(q.x >> 16);
    VT[(v4 + 2) * GT + t] = (u16)(q.y & 0xffffu);
    VT[(v4 + 3) * GT + t] = (u16)(q.y >> 16);
  }
  f32x4 ot[4];
#pragma unroll
  for (int i = 0; i < 4; ++i) ot[i] = f32x4{0.f, 0.f, 0.f, 0.f};
#pragma unroll
  for (int dir = 0; dir < 2; ++dir) {
    if (dir) __syncthreads();
#pragma unroll
    for (int k = 0; k < 4; ++k) {
      const int u = tid + 256 * k, t = u >> 4, d4 = (u & 15) * 4;
      const f32x4 cum = dir ? gcB[k] : gcF[k];
      const u32x2 q2 = gq[k];
      const u32x2 k2 = gk[k];
      const float e0 = __expf(cum[0]), e1 = __expf(cum[1]), e2 = __expf(cum[2]), e3 = __expf(cum[3]);
      const u32x2 qo = {pack2(lo2f(q2.x) * 0.125f * e0, hi2f(q2.x) * 0.125f * e1), pack2(lo2f(q2.y) * 0.125f * e2, hi2f(q2.y) * 0.125f * e3)};
      const u32x2 ko = {pack2(lo2f(k2.x) / e0, hi2f(k2.x) / e1), pack2(lo2f(k2.y) / e2, hi2f(k2.y) / e3)};
      *(u32x2*)(QH + t * GT + d4) = qo;
      *(u32x2*)(KH + t * GT + d4) = ko;
      const int d = t;
      const u32x2 s4 = dir ? gsB[k] : gsF[k];
      ST[(d4 + 0) * GT + d] = (u16)(s4.x & 0xffffu);
      ST[(d4 + 1) * GT + d] = (u16)(s4.x >> 16);
      ST[(d4 + 2) * GT + d] = (u16)(s4.y & 0xffffu);
      ST[(d4 + 3) * GT + d] = (u16)(s4.y >> 16);
    }
    __syncthreads();
    bf16x8 qf[2];
    qf[0] = *(const bf16x8*)(QH + (16 * w + l15) * GT + quad * 8);
    qf[1] = *(const bf16x8*)(QH + (16 * w + l15) * GT + 32 + quad * 8);
    f32x4 st[4];
#pragma unroll
    for (int sti = 0; sti < 4; ++sti) {
      const bf16x8 k0 = *(const bf16x8*)(KH + (sti * 16 + l15) * GT + quad * 8);
      const bf16x8 k1 = *(const bf16x8*)(KH + (sti * 16 + l15) * GT + 32 + quad * 8);
      f32x4 z = f32x4{0.f, 0.f, 0.f, 0.f};
      z = __builtin_amdgcn_mfma_f32_16x16x32_bf16(k0, qf[0], z, 0, 0, 0);
      st[sti] = __builtin_amdgcn_mfma_f32_16x16x32_bf16(k1, qf[1], z, 0, 0, 0);
      const int t = 16 * w + l15;
#pragma unroll
      for (int jj = 0; jj < 4; ++jj) {
        const int sidx = sti * 16 + quad * 4 + jj;
        const bool keep = dir ? (sidx >= t) : (sidx <= t);
        st[sti][jj] = keep ? st[sti][jj] : 0.f;
      }
    }
#pragma unroll
    for (int kk = 0; kk < 2; ++kk) {
      const u32x4 pu = {pack2(st[2 * kk][0], st[2 * kk][1]), pack2(st[2 * kk][2], st[2 * kk][3]),
                        pack2(st[2 * kk + 1][0], st[2 * kk + 1][1]), pack2(st[2 * kk + 1][2], st[2 * kk + 1][3])};
      const bf16x8 pf = __builtin_bit_cast(bf16x8, pu);
#pragma unroll
      for (int vt = 0; vt < 4; ++vt) {
        const u32x2 v0 = *(const u32x2*)(VT + (vt * 16 + l15) * GT + kk * 32 + quad * 4);
        const u32x2 v1 = *(const u32x2*)(VT + (vt * 16 + l15) * GT + kk * 32 + 16 + quad * 4);
        const u32x4 vu = {v0.x, v0.y, v1.x, v1.y};
        ot[vt] = __builtin_amdgcn_mfma_f32_16x16x32_bf16(__builtin_bit_cast(bf16x8, vu), pf, ot[vt], 0, 0, 0);
      }
    }
#pragma unroll
    for (int ks = 0; ks < 2; ++ks)
#pragma unroll
      for (int vt = 0; vt < 4; ++vt) {
        const bf16x8 sf = *(const bf16x8*)(ST + (vt * 16 + l15) * GT + ks * 32 + quad * 8);
        ot[vt] = __builtin_amdgcn_mfma_f32_16x16x32_bf16(sf, qf[ks], ot[vt], 0, 0, 0);
      }
  }
  {
    float ss = 0.f;
#pragma unroll
    for (int vt = 0; vt < 4; ++vt)
#pragma unroll
      for (int jj = 0; jj < 4; ++jj) ss += ot[vt][jj] * ot[vt][jj];
    ss += __shfl_xor(ss, 16);
    ss += __shfl_xor(ss, 32);
    const float rstd = rsqrtf(ss * (1.f / 64.f) + 1e-6f);
    const int row = r0 + 16 * w + l15;
    const float* gn = p->in[22] + l * 64;
    u16* OC = (u16*)(p->ws + OFF_OC);
#pragma unroll
    for (int vt = 0; vt < 4; ++vt) {
      const int v = vt * 16 + quad * 4;
      const f32x4 g4 = gg4[vt];
      const u32x2 rq = grq[vt];
      const float y0 = ot[vt][0] * rstd * g4[0] * silu_f(lo2f(rq.x));
      const float y1 = ot[vt][1] * rstd * g4[1] * silu_f(hi2f(rq.x));
      const float y2 = ot[vt][2] * rstd * g4[2] * silu_f(lo2f(rq.y));
      const float y3 = ot[vt][3] * rstd * g4[3] * silu_f(hi2f(rq.y));
      const u32x2 o = {pack2(y0, y1), pack2(y2, y3)};
      *(u32x2*)(OC + (size_t)row * 256 + h * 64 + v) = o;
    }
  }
}

struct Seg { const u16* K; const u16* Vt; int ks, vs, nk; };

template <int QT>
DEV void attn_item(const u16* __restrict__ Q, int qs, Seg s0, Seg s1, u16* __restrict__ O, int os, u16* sm,
                          bool na_mode, const float* rpb_h, int na_rowoff) {
  const int tid = otid(), lane = tid & 63, w = tid >> 6, quad = lane >> 4, l15 = lane & 15;
  const int qbase = w * 16 * QT;
  bf16x8 qf[QT][2];
#pragma unroll
  for (int qt = 0; qt < QT; ++qt)
#pragma unroll
    for (int ks = 0; ks < 2; ++ks)
      qf[qt][ks] = *(const bf16x8*)(Q + (size_t)(qbase + qt * 16 + l15) * qs + ks * 32 + quad * 8);
  f32x4 ot[4][QT];
  float mrow[QT], lrow[QT];
#pragma unroll
  for (int qt = 0; qt < QT; ++qt) {
    mrow[qt] = -1e30f; lrow[qt] = 0.f;
#pragma unroll
    for (int dt = 0; dt < 4; ++dt) ot[dt][qt] = f32x4{0.f, 0.f, 0.f, 0.f};
  }
  const int nt0 = s0.nk >> 6, nt = nt0 + (s1.nk >> 6);
  const int lr = tid >> 3, lc = (tid & 7) * 8;
  const int ksw = ((tid & 7) ^ ((lr >> 1) & 7)) * 8;
  const int kr0c = quad ^ (l15 >> 1);
  u32x4 rk[2][2], rv[2][2];
#define ATT_LOAD(S, T)                                                                  \
  {                                                                                     \
    const int _t = (T);                                                                 \
    const bool _f = _t < nt0;                                                           \
    const u16* _K = _f ? s0.K : s1.K; const u16* _V = _f ? s0.Vt : s1.Vt;               \
    const int _ks = _f ? s0.ks : s1.ks, _vs = _f ? s0.vs : s1.vs;                       \
    const int _k0 = (_f ? _t : _t - nt0) * 64;                                          \
    const u16* _kp = _K + (size_t)(_k0 + lr) * _ks + lc;                                \
    rk[S][0] = *(const u32x4*)_kp; rk[S][1] = *(const u32x4*)(_kp + (size_t)32 * _ks);  \
    const u16* _vp = _V + (size_t)lr * _vs + _k0 + lc;                                  \
    rv[S][0] = *(const u32x4*)_vp; rv[S][1] = *(const u32x4*)(_vp + (size_t)32 * _vs);  \
  }
#define ATT_STORE(S, BUF)                                                               \
  {                                                                                     \
    u16* _b = sm + (BUF) * (128 * LDT);                                                 \
    *(u32x4*)(_b + lr * 64 + ksw) = rk[S][0]; *(u32x4*)(_b + (lr + 32) * 64 + ksw) = rk[S][1]; \
    *(u32x4*)(_b + 64 * LDT + lr * LDT + lc) = rv[S][0];                                \
    *(u32x4*)(_b + 64 * LDT + (lr + 32) * LDT + lc) = rv[S][1];                         \
  }
  ATT_LOAD(0, 0);
  ATT_LOAD(1, 1);
  lds_barrier();
  ATT_STORE(0, 0);
  float* rpl = (float*)(sm + 2 * 128 * LDT);
  if (na_mode) { for (int i = tid; i < 15 * 31; i += 256) rpl[i] = rpb_h[i]; }
  lds_barrier();
  const float sc = 0.125f * 1.44269504088896f;
  for (int t2 = 0; t2 < nt; t2 += 2) {
#pragma unroll
  for (int hh = 0; hh < 2; ++hh) {
    const int t = t2 + hh;
    const u16* cK = sm + hh * (128 * LDT);
    const u16* cV = cK + 64 * LDT;
    ATT_LOAD(hh, min(t + 2, nt - 1));
    f32x4 st[4][QT];
#pragma unroll
    for (int kt = 0; kt < 4; ++kt) {
      bf16x8 k0 = *(const bf16x8*)(cK + (kt * 16 + l15) * 64 + kr0c * 8);
      bf16x8 k1 = *(const bf16x8*)(cK + (kt * 16 + l15) * 64 + (kr0c ^ 4) * 8);
#pragma unroll
      for (int qt = 0; qt < QT; ++qt) {
        f32x4 z = f32x4{0.f, 0.f, 0.f, 0.f};
        z = __builtin_amdgcn_mfma_f32_16x16x32_bf16(k0, qf[qt][0], z, 0, 0, 0);
        st[kt][qt] = __builtin_amdgcn_mfma_f32_16x16x32_bf16(k1, qf[qt][1], z, 0, 0, 0);
      }
    }
    float sce = sc;
    if (na_mode && t < nt0) {
      const float* rp = rpl + (na_rowoff + t) * 31;
      const int qcol = qbase + l15;
      const int win0 = min(max(qcol - 8, 0), 48);
#pragma unroll
      for (int kt = 0; kt < 4; ++kt)
#pragma unroll
        for (int j = 0; j < 4; ++j) {
          const int kc = kt * 16 + quad * 4 + j;
          const bool ok = (kc >= win0) && (kc < win0 + 16);
          const int bi = min(max(kc - qcol + 15, 0), 30);
          const float bias = rp[bi];
          st[kt][0][j] = ok ? (st[kt][0][j] * sc + bias * 1.44269504088896f) : -1e30f;
        }
      sce = 1.f;
    }
#pragma unroll
    for (int qt = 0; qt < QT; ++qt) {
      float mx = fmaxf(fmaxf(st[0][qt][0], st[0][qt][1]), fmaxf(st[0][qt][2], st[0][qt][3]));
#pragma unroll
      for (int kt = 1; kt < 4; ++kt)
        mx = fmaxf(mx, fmaxf(fmaxf(st[kt][qt][0], st[kt][qt][1]), fmaxf(st[kt][qt][2], st[kt][qt][3])));
      mx = fmaxf(mx, __shfl_xor(mx, 16));
      mx = fmaxf(mx, __shfl_xor(mx, 32));
      const float mold = mrow[qt];
      const float mnew = fmaxf(mold, mx * sce);
      const float alpha = __builtin_amdgcn_exp2f(mold - mnew);
      mrow[qt] = mnew;
      float ls = 0.f;
#pragma unroll
      for (int kt = 0; kt < 4; ++kt)
#pragma unroll
        for (int j = 0; j < 4; ++j) {
          const float pv = __builtin_amdgcn_exp2f(__builtin_fmaf(st[kt][qt][j], sce, -mnew));
          st[kt][qt][j] = pv; ls += pv;
        }
      lrow[qt] = lrow[qt] * alpha + ls;
      if (__any(mnew != mold)) {
#pragma unroll
        for (int dt = 0; dt < 4; ++dt) ot[dt][qt] *= alpha;
      }
    }
#pragma unroll
    for (int kk = 0; kk < 2; ++kk) {
      bf16x8 pf[QT];
#pragma unroll
      for (int qt = 0; qt < QT; ++qt) {
        uint4 u = make_uint4(pack2(st[2 * kk][qt][0], st[2 * kk][qt][1]), pack2(st[2 * kk][qt][2], st[2 * kk][qt][3]),
                             pack2(st[2 * kk + 1][qt][0], st[2 * kk + 1][qt][1]), pack2(st[2 * kk + 1][qt][2], st[2 * kk + 1][qt][3]));
        pf[qt] = __builtin_bit_cast(bf16x8, u);
      }
#pragma unroll
      for (int dt = 0; dt < 4; ++dt) {
        uint2 v0 = *(const uint2*)(cV + (dt * 16 + l15) * LDT + kk * 32 + quad * 4);
        uint2 v1 = *(const uint2*)(cV + (dt * 16 + l15) * LDT + kk * 32 + 16 + quad * 4);
        bf16x8 vf = __builtin_bit_cast(bf16x8, make_uint4(v0.x, v0.y, v1.x, v1.y));
#pragma unroll
        for (int qt = 0; qt < QT; ++qt)
          ot[dt][qt] = __builtin_amdgcn_mfma_f32_16x16x32_bf16(vf, pf[qt], ot[dt][qt], 0, 0, 0);
      }
    }
    ATT_STORE(hh ^ 1, hh ^ 1);
    lds_barrier();
  }
  }
#pragma unroll
  for (int qt = 0; qt < QT; ++qt) {
    float ls = lrow[qt];
    ls += __shfl_xor(ls, 16);
    ls += __shfl_xor(ls, 32);
    const float inv = 1.f / ls;
    const int q = qbase + qt * 16 + l15;
#pragma unroll
    for (int dt = 0; dt < 4; ++dt)
      *(uint2*)(O + (size_t)q * os + dt * 16 + quad * 4) =
          make_uint2(pack2(ot[dt][qt][0] * inv, ot[dt][qt][1] * inv), pack2(ot[dt][qt][2] * inv, ot[dt][qt][3] * inv));
  }
#undef ATT_LOAD
#undef ATT_STORE
}

DEV void phase_attention(PP p, int l, u16* sm) {
  const u16* PROJ = (const u16*)(p->ws + OFF_PROJ);
  u16* OA = (u16*)(p->ws + OFF_OA);
  u16* OB = (u16*)(p->ws + OFF_OB);
  const int NG2 = 34 * 32;
  const int total = NG2 + 512 + 512 + 256 + 512;
  for (int item = VB; item < total; item += VG) {
    int idx = item;
    if (idx < NG2) { gla_g2_item(p, l, idx); continue; }
    idx -= NG2;
    if (idx < 512) {
      int b = idx >> 8, hq = (idx >> 5) & 7, qb = idx & 31;
      if (VG == 512) {
        const int v = (NG2 + idx) & 511, blk = v >> 1, xcd = blk & 7, slot = blk >> 3;
        const int pair = xcd >> 1, wv = ((((xcd & 1) << 5) + slot) << 1) | (v & 1);
        b = pair >> 1; hq = (pair & 1) * 4 + (wv >> 5); qb = wv & 31;
      }
      const int kvh = hq >> 2;
      const size_t rowb = 8192 + (size_t)b * 4096;
      Seg s0{PROJ + rowb * NP + C_KB + kvh * 64, (const u16*)(p->ws + OFF_VTB_S) + (size_t)(b * 2 + kvh) * 64 * LDVS, NP, LDVS, 4096};
      Seg s1{(const u16*)(p->ws + OFF_CKB) + (size_t)((l * 2 + b) * 2 + kvh) * 512 * 64,
             (const u16*)(p->ws + OFF_CVTB) + (size_t)((l * 2 + b) * 2 + kvh) * 64 * 512, 64, 512, 512};
      attn_item<2>(PROJ + (rowb + qb * 128) * NP + C_QB + hq * 64, NP, s0, s1, OB + (rowb + qb * 128) * 512 + hq * 64, 512, sm,
                   false, nullptr, 0);
      continue;
    }
    idx -= 512;
    if (idx < 512) {
      int b = idx >> 8, h = (idx >> 6) & 3, r = idx & 63;
      if (VG == 512) {
        const int v = (NG2 + 512 + idx) & 511, blk = v >> 1, xcd = blk & 7, slot = blk >> 3;
        b = xcd >> 2; h = xcd & 3; r = (slot << 1) | (v & 1);
      }
      const int kr0 = min(max(r - 4, 0), 56);
      const size_t rowb = 8192 + (size_t)b * 4096;
      Seg s0{PROJ + (rowb + kr0 * 64) * NP + C_KA + h * 64,
             (const u16*)(p->ws + OFF_VTA_S) + (size_t)(b * 4 + h) * 64 * LDVS + kr0 * 64, NP, LDVS, 512};
      Seg s1{(const u16*)(p->ws + OFF_CKA) + (size_t)((l * 2 + b) * 4 + h) * 512 * 64,
             (const u16*)(p->ws + OFF_CVTA) + (size_t)((l * 2 + b) * 4 + h) * 64 * 512, 64, 512, 512};
      attn_item<1>(PROJ + (rowb + r * 64) * NP + C_QA + h * 64, NP, s0, s1, OA + (rowb + r * 64) * 256 + h * 64, 256, sm,
                   true, p->in[17] + (size_t)(l * 4 + h) * 15 * 31, kr0 - r + 7);
      continue;
    }
    idx -= 512;
    if (idx < 256) {
      const int b = idx >> 3, h = (idx >> 1) & 3, qb = idx & 1;
      const size_t rowb = (size_t)b * 256;
      Seg s0{PROJ + rowb * NP + C_KA + h * 64, (const u16*)(p->ws + OFF_VTA_P) + (size_t)(b * 4 + h) * 64 * 256, NP, 256, 256};
      Seg s1{nullptr, nullptr, 0, 0, 0};
      attn_item<2>(PROJ + (rowb + qb * 128) * NP + C_QA + h * 64, NP, s0, s1, OA + (rowb + qb * 128) * 256 + h * 64, 256, sm,
                   false, nullptr, 0);
      continue;
    }
    idx -= 256;
    {
      const int b = idx >> 4, hq = (idx >> 1) & 7, qb = idx & 1, kvh = hq >> 2;
      const size_t rowb = (size_t)b * 256;
      Seg s0{PROJ + rowb * NP + C_KB + kvh * 64, (const u16*)(p->ws + OFF_VTB_P) + (size_t)(b * 2 + kvh) * 64 * 256, NP, 256, 256};
      Seg s1{nullptr, nullptr, 0, 0, 0};
      attn_item<2>(PROJ + (rowb + qb * 128) * NP + C_QB + hq * 64, NP, s0, s1, OB + (rowb + qb * 128) * 512 + hq * 64, 512, sm,
                   false, nullptr, 0);
    }
  }
}

DEV void phase_conv(PP p, int l) {
  const u16* U = (const u16*)(p->ws + OFF_PROJ);
  u16* ACT = (u16*)(p->ws + OFF_ACT);
  const float* cw = p->in[28] + (size_t)l * 3 * 5632;
  const float* cb = p->in[29] + (size_t)l * 5632;
  const int total = 2048 * 352;
  const int tid = otid();
  for (int u = VB * 256 + tid; u < total; u += VG * 256) {
    const int rc = u / 352, cgp = u % 352;
    const int c0 = cgp * 8, r0 = rc * 8;
    const int seqlen = r0 < 8192 ? 256 : 4096;
    const int pos = r0 & (seqlen - 1);
    const bool hasprev = pos != 0, hasnext = (pos + 8) < seqlen;
    u32x4 ra[10], rg[10];
    const u32x4 zero4 = {0u, 0u, 0u, 0u};
#pragma unroll
    for (int i = 0; i < 10; ++i) {
      const bool ok = (i == 0) ? hasprev : (i == 9 ? hasnext : true);
      const int row = ok ? (r0 - 1 + i) : r0;
      u32x4 a = *(const u32x4*)(U + (size_t)row * 5632 + c0);
      u32x4 g = *(const u32x4*)(U + (size_t)row * 5632 + 2816 + c0);
      ra[i] = ok ? a : zero4;
      rg[i] = ok ? g : zero4;
    }
    float wa[3][8], wg[3][8], ba[8], bg[8];
#pragma unroll
    for (int j = 0; j < 3; ++j) {
      f32x4 t0 = *(const f32x4*)(cw + j * 5632 + c0), t1 = *(const f32x4*)(cw + j * 5632 + c0 + 4);
      f32x4 t2 = *(const f32x4*)(cw + j * 5632 + 2816 + c0), t3 = *(const f32x4*)(cw + j * 5632 + 2816 + c0 + 4);
#pragma unroll
      for (int q = 0; q < 4; ++q) { wa[j][q] = t0[q]; wa[j][4 + q] = t1[q]; wg[j][q] = t2[q]; wg[j][4 + q] = t3[q]; }
    }
    {
      f32x4 t0 = *(const f32x4*)(cb + c0), t1 = *(const f32x4*)(cb + c0 + 4);
      f32x4 t2 = *(const f32x4*)(cb + 2816 + c0), t3 = *(const f32x4*)(cb + 2816 + c0 + 4);
#pragma unroll
      for (int q = 0; q < 4; ++q) { ba[q] = t0[q]; ba[4 + q] = t1[q]; bg[q] = t2[q]; bg[4 + q] = t3[q]; }
    }
#pragma unroll
    for (int i = 0; i < 8; ++i) {
      u32x4 o;
#pragma unroll
      for (int q = 0; q < 4; ++q) {
        float a0 = ba[2 * q] + lo2f(ra[i][q]) * wa[0][2 * q] + lo2f(ra[i + 1][q]) * wa[1][2 * q] + lo2f(ra[i + 2][q]) * wa[2][2 * q];
        float a1 = ba[2 * q + 1] + hi2f(ra[i][q]) * wa[0][2 * q + 1] + hi2f(ra[i + 1][q]) * wa[1][2 * q + 1] + hi2f(ra[i + 2][q]) * wa[2][2 * q + 1];
        float g0 = bg[2 * q] + lo2f(rg[i][q]) * wg[0][2 * q] + lo2f(rg[i + 1][q]) * wg[1][2 * q] + lo2f(rg[i + 2][q]) * wg[2][2 * q];
        float g1 = bg[2 * q + 1] + hi2f(rg[i][q]) * wg[0][2 * q + 1] + hi2f(rg[i + 1][q]) * wg[1][2 * q + 1] + hi2f(rg[i + 2][q]) * wg[2][2 * q + 1];
        o[q] = pack2(a0 * silu_f(g0), a1 * silu_f(g1));
      }
      *(u32x4*)(ACT + (size_t)(r0 + i) * LDACT + c0) = o;
    }
  }
}

__global__ void __launch_bounds__(512, 2) trunk_megakernel(Params p_unused) {
  extern __shared__ __attribute__((aligned(16))) unsigned char smem_raw[];
  u16* smg = (u16*)smem_raw;
  u16* sm = (u16*)(smem_raw + vhalf() * HALF_LDS);
  float* smf = (float*)sm;
  cg::grid_group grid = cg::this_grid();
  volatile LAS unsigned* bst = (volatile LAS unsigned*)(smem_raw + (LDS_BYTES - 16));
  if (threadIdx.x == 0) { bst[0] = 0u; bst[1] = 0u; }
  __syncthreads();
  XcdBarrier xb;
  { PP p = load_params(); xb = xcd_barrier_post((unsigned*)(p->ws + OFF_BAR), bst); }

  { PP p = load_params(); phase_mod(p, smf); }
  { PP p = load_params(); phase_cache(p); }
  { PP p = load_params(); if (p->ws == nullptr) grid.sync(); }
  xcd_barrier(xb);

#pragma unroll 1
  for (int l = 0; l < 4; ++l) {
    { PP p = load_params(); phase_convert_weights(p, l, smf); }
    { PP p = load_params(); phase_norm(p, l, 0); }
    xcd_barrier(xb);
    { PP p = load_params();
      phase_gemm_store((const u16*)(p->ws + OFF_H), LDH, (const u16*)(p->ws + OFF_WT_IN), LDW1, 1024, 23, (u16*)(p->ws + OFF_PROJ), NP, smg, p, l, true); }
    xcd_barrier(xb);
    { PP p = load_params();
      for (int item = VB; item < 1024; item += VG) gla_g1_item(p, l, item >> 2, item & 3, smf); }
    xcd_barrier(xb);
    { PP p = load_params(); phase_attention(p, l, sm); }
    xcd_barrier(xb);
    { PP p = load_params();
      for (int item = VB; item < 1024; item += VG) gla_g3_item(p, l, item >> 2, item & 3, sm); }
    xcd_barrier(xb);
    { PP p = load_params(); phase_gemm_merge(p, smg); }
    xcd_barrier(xb);
    { PP p = load_params();
      phase_gemm_resid((const u16*)(p->ws + OFF_H), LDH, (const u16*)(p->ws + OFF_WT_OUT), LDW1, 1024, (u16*)(p->ws + OFF_XB),
                       (const float*)(p->ws + OFF_MOD) + (size_t)l * 3 * 6144 + 2048, smg, nullptr); }
    xcd_barrier(xb);
    { PP p = load_params(); phase_norm(p, l, 1); }
    xcd_barrier(xb);
    { PP p = load_params(); phase_gemm_up_conv(p, l, smg); }
    xcd_barrier(xb);
    { PP p = load_params();
      phase_gemm_resid((const u16*)(p->ws + OFF_ACT), LDACT, (const u16*)(p->ws + OFF_WT_DN), LDACT, DFF, (u16*)(p->ws + OFF_XB),
                       (const float*)(p->ws + OFF_MOD) + (size_t)l * 3 * 6144 + 5120, smg, l == 3 ? p->out : nullptr, p, l); }
    xcd_barrier(xb);
  }
}

extern "C" void kernel_launch(void* const* d_in, const int* in_sizes, int n_in, void* d_out, int out_size, void* d_ws,
                              size_t ws_size, hipStream_t stream) {
  static int grid_blocks = 0;
  if (grid_blocks == 0) {
    if (n_in != 31 || ws_size < WS_END) {
      fprintf(stderr, "kernel_launch: unexpected inputs (n_in %d) or workspace too small (%zu < %zu)\n", n_in, ws_size, (size_t)WS_END);
      grid_blocks = -1;
      return;
    }
    int dev = 0, cus = 0, per_cu = 0;
    hipGetDevice(&dev);
    hipDeviceGetAttribute(&cus, hipDeviceAttributeMultiprocessorCount, dev);
    hipFuncSetAttribute((const void*)trunk_megakernel, hipFuncAttributeMaxDynamicSharedMemorySize, LDS_BYTES);
    hipOccupancyMaxActiveBlocksPerMultiprocessor(&per_cu, (const void*)trunk_megakernel, 512, LDS_BYTES);
    per_cu = 1;
    grid_blocks = cus * per_cu;
  }
  if (grid_blocks < 0) return;
  Params p{};
  for (int i = 0; i < 31; ++i) p.in[i] = (const float*)d_in[i];
  p.out = (float*)d_out;
  p.ws = (unsigned char*)d_ws;
  if (hipMemsetAsync((unsigned char*)d_ws + OFF_BAR, 0, 16384, stream) != hipSuccess) fprintf(stderr, "kernel_launch: memset of barrier words failed\n");
  void* args[] = {&p};
  hipError_t e = hipLaunchCooperativeKernel((const void*)trunk_megakernel, dim3(grid_blocks), dim3(512), args, LDS_BYTES, stream);
  if (e != hipSuccess) fprintf(stderr, "cooperative launch failed: %s (grid %d)\n", hipGetErrorString(e), grid_blocks);
}
```
